# Optimizing an MI355X kernel written in HIP

```python
import jax, jax.numpy as jnp
from jax import lax
import numpy as np

D_MODEL = 2048
BATCH = 8
SEQ = 2048
DEPTH = 2

MIX_WIDTH = D_MODEL
RET_HEADS = 4
RET_DK = MIX_WIDTH // 16
RET_DV = MIX_WIDTH // 16
RET_WIDTH = RET_HEADS * RET_DV
RET_CHUNK = 128
ROPE_THETA = 10000.0
SSD_WIDTH = MIX_WIDTH // 2
SSD_HEADDIM = 64
SSD_HEADS = SSD_WIDTH // SSD_HEADDIM
SSD_STATE = 128
SSD_GROUPS = 2
SSD_CONV = 4
SSD_CONV_DIM = SSD_WIDTH + 2 * SSD_GROUPS * SSD_STATE
SSD_CHUNK = 128
HGRN_WIDTH = MIX_WIDTH // 4
HGRN_HEADS = 4
HGRN_EXPAND = 128
HGRN_DV = HGRN_WIDTH // HGRN_HEADS
HGRN_FDIM = HGRN_HEADS * HGRN_EXPAND
HGRN_CHUNK = 64
LB_FLOOR = 1e-30
IN_SPLITS = (RET_HEADS * RET_DK, RET_HEADS * RET_DK, RET_WIDTH, RET_WIDTH,
             SSD_WIDTH, SSD_CONV_DIM, SSD_HEADS,
             HGRN_FDIM, HGRN_FDIM, HGRN_WIDTH, HGRN_WIDTH)
IN_DIM = sum(IN_SPLITS)
N_GROUPS = 4
EXPERTS_PER_GROUP = 8
N_EXPERTS = N_GROUPS * EXPERTS_PER_GROUP
TOP_K = 2
D_EXPERT = D_MODEL // 4
MOE_BLOCK = 128
EPS = 1e-6

kernel_name = "hymba_style_ret_ssd_hgrn2_hmoe"


def rms_norm(x, w):
    x32 = x.astype(jnp.float32)
    y = x32 * lax.rsqrt(jnp.mean(x32 * x32, axis=-1, keepdims=True) + EPS)
    return (y * w.astype(jnp.float32)).astype(x.dtype)


def rms_norm_plain(x):
    x32 = x.astype(jnp.float32)
    return (x32 * lax.rsqrt(jnp.mean(x32 * x32, axis=-1, keepdims=True) + EPS)).astype(x.dtype)


def rotary(x):
    t, dk = x.shape[1], x.shape[-1]
    half = dk // 2
    inv = 1.0 / (ROPE_THETA ** (jnp.arange(half, dtype=jnp.float32) / half))
    ang = jnp.arange(t, dtype=jnp.float32)[:, None] * inv[None, :]
    cos, sin = jnp.cos(ang)[:, None, :], jnp.sin(ang)[:, None, :]
    x32 = x.astype(jnp.float32)
    x1, x2 = x32[..., :half], x32[..., half:]
    return jnp.concatenate([x1 * cos - x2 * sin, x1 * sin + x2 * cos], axis=-1).astype(x.dtype)


def chunked_recurrence(q, k, v, log_a, chunk):
    bsz, t, h, dk = q.shape
    dv = v.shape[-1]
    n = t // chunk

    def blocks(a):
        return a.reshape(bsz, n, chunk, h, a.shape[-1]).transpose(1, 0, 3, 2, 4).astype(jnp.float32)

    causal = jnp.tril(jnp.ones((chunk, chunk), dtype=bool))[:, :, None]
    vector_decay = log_a.shape[-1] > 1

    def step(state, inp):
        qc, kc, vc, lc = inp
        cum = jnp.cumsum(lc, axis=2)
        last = cum[:, :, -1:, :]
        diff = cum[:, :, :, None, :] - cum[:, :, None, :, :]
        decay = jnp.where(causal, jnp.exp(jnp.where(causal, diff, 0.0)), 0.0)
        if vector_decay:
            scores = jnp.einsum('bhik,bhjk,bhijk->bhij', qc, kc, decay)
        else:
            scores = jnp.einsum('bhik,bhjk->bhij', qc, kc) * decay[..., 0]
        out = (jnp.einsum('bhij,bhjv->bhiv', scores, vc)
               + jnp.einsum('bhik,bhkv->bhiv', qc * jnp.exp(cum), state))
        state = (jnp.swapaxes(jnp.exp(last), 2, 3) * state
                 + jnp.einsum('bhjk,bhjv->bhkv', kc * jnp.exp(last - cum), vc))
        return state, out

    s0 = jnp.zeros((bsz, h, dk, dv), jnp.float32)
    _, out = lax.scan(step, s0, (blocks(q), blocks(k), blocks(v), blocks(log_a)))
    return out.transpose(1, 0, 3, 2, 4).reshape(bsz, t, h, dv).astype(v.dtype)


def retention(q, k, v, g):
    bsz, t, _ = q.shape
    q = rotary(q.reshape(bsz, t, RET_HEADS, RET_DK))
    k = rotary(k.reshape(bsz, t, RET_HEADS, RET_DK)) * (RET_DK ** -0.5)
    v = v.reshape(bsz, t, RET_HEADS, RET_DV)
    log_gamma = jnp.log(1.0 - 2.0 ** (-5.0 - jnp.arange(RET_HEADS, dtype=jnp.float32)))
    log_a = jnp.broadcast_to(log_gamma[:, None], (bsz, t, RET_HEADS, 1))
    o = chunked_recurrence(q, k, v, log_a, RET_CHUNK)
    o = rms_norm_plain(o).reshape(bsz, t, RET_WIDTH)
    return jax.nn.silu(g) * o


def ssd(z, xbc, dt_raw, conv_w, conv_b, dt_bias, a_log, d_skip, norm_w):
    bsz, t, _ = z.shape
    xbc = lax.conv_general_dilated(xbc, conv_w[:, None, :].astype(xbc.dtype), window_strides=(1,),
                                   padding=[(SSD_CONV - 1, 0)],
                                   dimension_numbers=('NWC', 'WIO', 'NWC'),
                                   feature_group_count=SSD_CONV_DIM)
    xbc = jax.nn.silu(xbc + conv_b)
    xs, bm, cm = jnp.split(xbc, [SSD_WIDTH, SSD_WIDTH + SSD_GROUPS * SSD_STATE], axis=-1)
    rep = SSD_HEADS // SSD_GROUPS
    xs = xs.reshape(bsz, t, SSD_HEADS, SSD_HEADDIM)
    bm = jnp.repeat(bm.reshape(bsz, t, SSD_GROUPS, SSD_STATE), rep, axis=2)
    cm = jnp.repeat(cm.reshape(bsz, t, SSD_GROUPS, SSD_STATE), rep, axis=2)
    dt = jax.nn.softplus(dt_raw.astype(jnp.float32) + dt_bias.astype(jnp.float32))
    log_a = (dt * -jnp.exp(a_log.astype(jnp.float32)))[..., None]
    y = chunked_recurrence(cm, bm * dt[..., None].astype(bm.dtype), xs, log_a, SSD_CHUNK)
    y = y + d_skip[:, None] * xs
    y = (y.reshape(bsz, t, SSD_WIDTH) * jax.nn.silu(z)).reshape(bsz, t, SSD_GROUPS, SSD_WIDTH // SSD_GROUPS)
    return rms_norm_plain(y).reshape(bsz, t, SSD_WIDTH) * norm_w


def hgrn2(q, f, i, g, lb, norm_w):
    bsz, t, _ = q.shape
    q = jax.nn.silu(q).reshape(bsz, t, HGRN_HEADS, HGRN_EXPAND) * (HGRN_EXPAND ** -0.5)
    f32 = f.astype(jnp.float32)
    log_lb = jnp.log(jnp.maximum(lb, LB_FLOOR))
    log_f = jnp.logaddexp(log_lb, jnp.log1p(-lb) + jax.nn.log_sigmoid(f32))
    k = (1.0 - lb) * jax.nn.sigmoid(-f32)
    log_f = log_f.reshape(bsz, t, HGRN_HEADS, HGRN_EXPAND)
    k = k.reshape(bsz, t, HGRN_HEADS, HGRN_EXPAND).astype(q.dtype)
    v = i.reshape(bsz, t, HGRN_HEADS, HGRN_DV)
    o = chunked_recurrence(q, k, v, log_f, HGRN_CHUNK)
    o = rms_norm_plain(o).reshape(bsz, t, HGRN_WIDTH) * norm_w
    return jax.nn.silu(g) * o


def hier_moe(u, wg, bg, we, be, w_gate, w_up, w_down):
    bsz, t, d = u.shape
    n = bsz * t
    uf = u.reshape(n, d)
    p_group = jax.nn.softmax((uf @ wg + bg).astype(jnp.float32), axis=-1)
    g_idx = jnp.argmax(p_group, axis=-1)
    g_gate = jnp.max(p_group, axis=-1)
    e_logits = (uf @ we + be).astype(jnp.float32).reshape(n, N_GROUPS, EXPERTS_PER_GROUP)
    e_logits = jnp.take_along_axis(e_logits, g_idx[:, None, None], axis=1)[:, 0]
    top_logits, top_idx = lax.top_k(e_logits, TOP_K)
    top_w = jax.nn.softmax(top_logits, axis=-1) * g_gate[:, None]
    expert_ids = (g_idx[:, None] * EXPERTS_PER_GROUP + top_idx).reshape(-1).astype(jnp.int32)
    token_ids = jnp.repeat(jnp.arange(n, dtype=jnp.int32), TOP_K)
    slot_w = top_w.reshape(-1)
    s = n * TOP_K
    order = jnp.argsort(expert_ids)
    sorted_e = expert_ids[order]
    counts = jnp.bincount(expert_ids, length=N_EXPERTS)
    padded = ((counts + MOE_BLOCK - 1) // MOE_BLOCK) * MOE_BLOCK
    starts = jnp.cumsum(counts) - counts
    pends = jnp.cumsum(padded)
    pstarts = pends - padded
    dest = pstarts[sorted_e] + (jnp.arange(s, dtype=jnp.int32) - starts[sorted_e])
    p_total = s + N_EXPERTS * MOE_BLOCK
    nblk = p_total // MOE_BLOCK
    buf_tok = jnp.zeros((p_total,), jnp.int32).at[dest].set(token_ids[order])
    buf_w = jnp.zeros((p_total,), jnp.float32).at[dest].set(slot_w[order])
    blk_e = jnp.clip(jnp.searchsorted(pends, jnp.arange(nblk) * MOE_BLOCK, side='right'), 0, N_EXPERTS - 1)

    def run_block(args):
        tok, e = args
        xb = uf[tok]
        hdn = jax.nn.silu(xb @ w_gate[e]) * (xb @ w_up[e])
        return hdn @ w_down[e]

    y = lax.map(run_block, (buf_tok.reshape(nblk, MOE_BLOCK), blk_e))
    y = y.reshape(p_total, d).astype(jnp.float32) * buf_w[:, None]
    out = jnp.zeros((n, d), jnp.float32).at[buf_tok].add(y)
    return out.astype(u.dtype).reshape(bsz, t, d)


def setup_inputs(seed: int = 0) -> dict:
    key = jax.random.key(seed)
    ks = jax.random.split(key, 24)
    nrm = lambda k, shape, scale: jax.random.normal(k, shape, jnp.float32) * scale
    dt = jnp.exp(jax.random.uniform(ks[5], (DEPTH, SSD_HEADS), jnp.float32)
                 * (jnp.log(0.1) - jnp.log(0.001)) + jnp.log(0.001))
    return {
        "x": nrm(ks[0], (BATCH, SEQ, D_MODEL), 1.0),
        "attn_norm_w": 1.0 + nrm(ks[1], (DEPTH, D_MODEL), 0.02),
        "w_in": nrm(ks[2], (DEPTH, D_MODEL, IN_DIM), D_MODEL ** -0.5),
        "ssd_conv_w": nrm(ks[3], (DEPTH, SSD_CONV, SSD_CONV_DIM), SSD_CONV ** -0.5),
        "ssd_conv_b": nrm(ks[4], (DEPTH, SSD_CONV_DIM), 0.02),
        "ssd_dt_bias": dt + jnp.log(-jnp.expm1(-dt)),
        "ssd_a_log": jnp.log(jax.random.uniform(ks[6], (DEPTH, SSD_HEADS), jnp.float32, 1.0, 16.0)),
        "ssd_d": 1.0 + nrm(ks[7], (DEPTH, SSD_HEADS), 0.1),
        "ssd_norm_w": 1.0 + nrm(ks[8], (DEPTH, SSD_WIDTH), 0.02),
        "hgrn_lower_bounds": 1.0 + nrm(ks[9], (DEPTH, HGRN_FDIM), 0.1),
        "hgrn_norm_w": 1.0 + nrm(ks[10], (DEPTH, HGRN_WIDTH), 0.02),
        "w_out": nrm(ks[11], (DEPTH, MIX_WIDTH, D_MODEL), MIX_WIDTH ** -0.5),
        "ffn_norm_w": 1.0 + nrm(ks[12], (DEPTH, D_MODEL), 0.02),
        "router_group_w": nrm(ks[13], (DEPTH, D_MODEL, N_GROUPS), D_MODEL ** -0.5),
        "router_group_b": nrm(ks[14], (DEPTH, N_GROUPS), 0.01),
        "router_expert_w": nrm(ks[15], (DEPTH, D_MODEL, N_EXPERTS), D_MODEL ** -0.5),
        "router_expert_b": nrm(ks[16], (DEPTH, N_EXPERTS), 0.01),
        "expert_w_gate": nrm(ks[17], (DEPTH, N_EXPERTS, D_MODEL, D_EXPERT), D_MODEL ** -0.5),
        "expert_w_up": nrm(ks[18], (DEPTH, N_EXPERTS, D_MODEL, D_EXPERT), D_MODEL ** -0.5),
        "expert_w_down": nrm(ks[19], (DEPTH, N_EXPERTS, D_EXPERT, D_MODEL), D_EXPERT ** -0.5),
        "final_norm_w": 1.0 + nrm(ks[20], (D_MODEL,), 0.02),
    }


def reference(x, attn_norm_w, w_in, ssd_conv_w, ssd_conv_b, ssd_dt_bias, ssd_a_log, ssd_d,
              ssd_norm_w, hgrn_lower_bounds, hgrn_norm_w, w_out, ffn_norm_w,
              router_group_w, router_group_b, router_expert_w, router_expert_b,
              expert_w_gate, expert_w_up, expert_w_down, final_norm_w):
    lb_sm = jax.nn.softmax(hgrn_lower_bounds.astype(jnp.float32), axis=0)
    lbs = jnp.maximum(jnp.cumsum(lb_sm, axis=0) - lb_sm[0], 0.0)
    split_points = [int(p) for p in np.cumsum(IN_SPLITS)[:-1]]
    h = x
    for l in range(DEPTH):
        u = rms_norm(h, attn_norm_w[l])
        p = u @ w_in[l]
        (rq, rk, rv, rg, sz, sxbc, sdt, hq, hf, hi, hg) = jnp.split(p, split_points, axis=-1)
        o_ret = retention(rq, rk, rv, rg)
        o_ssd = ssd(sz, sxbc, sdt, ssd_conv_w[l], ssd_conv_b[l], ssd_dt_bias[l],
                    ssd_a_log[l], ssd_d[l], ssd_norm_w[l])
        o_hgrn = hgrn2(hq, hf, hi, hg, lbs[l], hgrn_norm_w[l])
        h = h + jnp.concatenate([o_ret, o_ssd, o_hgrn], axis=-1) @ w_out[l]
        u = rms_norm(h, ffn_norm_w[l])
        h = h + hier_moe(u, router_group_w[l], router_group_b[l], router_expert_w[l],
                         router_expert_b[l], expert_w_gate[l], expert_w_up[l], expert_w_down[l])
    return rms_norm(h, final_norm_w)
```

```cpp
#include <hip/hip_runtime.h>
#include <cstdio>
#include <cstdint>

#ifndef MOE_FP8
#define MOE_FP8 1
#endif
#ifndef MK_LAUNCH_PER_PHASE
#define MK_LAUNCH_PER_PHASE 0
#endif

#define LAS __attribute__((address_space(3)))
#define GAS __attribute__((address_space(1)))
typedef unsigned short bf16;
typedef unsigned v4u __attribute__((ext_vector_type(4)));
typedef unsigned v2u __attribute__((ext_vector_type(2)));
typedef float f32x4 __attribute__((ext_vector_type(4)));
typedef float f32x2 __attribute__((ext_vector_type(2)));
typedef short bf16x8 __attribute__((ext_vector_type(8)));
typedef GAS unsigned gu32;
#define RLX_AGENT __ATOMIC_RELAXED, __HIP_MEMORY_SCOPE_AGENT
#define LDS_WAIT() asm volatile("s_waitcnt lgkmcnt(0)" ::: "memory")
#define VM_WAIT() asm volatile("s_waitcnt vmcnt(0)" ::: "memory")

constexpr int DM = 2048, NTOK = 16384, SEQ = 2048, NLAYER = 2;
constexpr int IN_DIM = 6672, NP = 6656;
constexpr int C_RQ = 0, C_RK = 512, C_RV = 1024, C_RG = 1536, C_SZ = 2048, C_SX = 3072, C_SB = 4096, C_SC = 4352, C_HQ = 4608, C_HF = 5120, C_HI = 5632, C_HG = 6144;
constexpr int DT_COL0 = 4608;
constexpr int NEXP = 32, DEXP = 512, CONVD = 1536;
constexpr int MAXTILES = 161, PADROWS = MAXTILES * 256;
constexpr float EPS = 1e-6f;

__host__ __device__ __forceinline__ size_t PB(size_t row, int col) { return ((size_t)(col >> 7) * NTOK + row) * 128 + (col & 127); }
__device__ __forceinline__ float bf2f(bf16 x) { return __uint_as_float(((unsigned)x) << 16); }
__device__ __forceinline__ unsigned f2bf(float f) { unsigned u = __float_as_uint(f); return (u + 0x7fffu + ((u >> 16) & 1u)) >> 16; }
typedef __bf16 bf16x2v __attribute__((ext_vector_type(2)));
__device__ __forceinline__ unsigned pk2(float lo, float hi) { const f32x2 v = {lo, hi}; return __builtin_bit_cast(unsigned, __builtin_convertvector(v, bf16x2v)); }
__device__ __forceinline__ bf16 f2bf1(float f) { return (bf16)pk2(f, f); }
__device__ __forceinline__ float siluf(float x) { return x * __builtin_amdgcn_rcpf(1.f + __expf(-x)); }
__device__ __forceinline__ float sigmf(float x) { return __builtin_amdgcn_rcpf(1.f + __expf(-x)); }
__device__ __forceinline__ float wave_sum(float v) {
#pragma unroll
    for (int o = 1; o < 64; o <<= 1) v += __shfl_xor(v, o);
    return v;
}

#define cvt2_fp8(a, b, old, hi) __builtin_amdgcn_cvt_pk_fp8_f32(__builtin_amdgcn_fmed3f((a), -448.f, 448.f), __builtin_amdgcn_fmed3f((b), -448.f, 448.f), (old), (hi))
namespace pg8 {
constexpr int BM = 256, BK = 64, HALF = 128, HTB = HALF * BK * 2, STAGE_BYTES = 8 * HTB, NXCD = 8, WGM = 8;
__host__ __device__ __forceinline__ int lds_byte(int r, int c) { const int st = (r >> 4) * 2 + (c >> 5), rr = r & 15, cc = c & 31, ob = rr * 64 + cc * 2; return st * 1024 + (ob ^ (((ob >> 9) & 1) << 5)); }
__host__ __device__ __forceinline__ void stage_rc(int b, int& R, int& C) { const int st = b / 1024, sb = b % 1024, swz = sb ^ (((sb >> 9) & 1) << 5); R = (st >> 1) * 16 + swz / 64; C = (st & 1) * 32 + (swz % 64) / 2; }
__host__ __device__ __forceinline__ int perm32(int rho) { const int n = rho >> 4, i = rho & 15; return 8 * (i >> 2) + 4 * n + (i & 3); }

struct Unit { int pm, pn, e, lt; };
struct Gemm { const bf16* A; const bf16* Bt; int M, N, K; unsigned wscale; };

struct StaticOrder {
    static constexpr bool GATHER = false;
    int nM, nN, nwg, G, c;
    __device__ void init(int M, int N, int G_, int c_) { nM = M / BM; nN = N / BM; nwg = nM * nN; G = G_; c = c_; }
    __device__ bool next(int i, Unit& u) const {
        const long L = (long)i * G + c; if (L >= nwg) return false;
        int wgid = (int)L; { const int q = nwg / NXCD, r = nwg % NXCD, xcd = wgid % NXCD, off = wgid / NXCD; wgid = (xcd < r ? xcd * (q + 1) : r * (q + 1) + (xcd - r) * q) + off; }
        const int nig = WGM * nN, gid = wgid / nig, fm = gid * WGM, gsz = (nM - fm) < WGM ? (nM - fm) : WGM;
        u.pm = fm + ((wgid % nig) % gsz); u.pn = (wgid % nig) / gsz; u.e = 0; u.lt = 0; return true;
    }
    __device__ __forceinline__ const char* a_base(const Gemm& g, const Unit& u) const { return (const char*)g.A + (size_t)u.pm * ((size_t)BM * g.K * 2); }
    __device__ __forceinline__ const char* b_base(const Gemm& g, const Unit& u) const { return (const char*)g.Bt + (size_t)u.pn * ((size_t)BM * g.K * 2); }
    __device__ __forceinline__ int gidx(int, int) const { return 0; }
};
template <bool GA> struct MoeOrder {
    static constexpr bool GATHER = GA;
    const LAS int* tmap; const LAS int* gtab; int ntiles, nN, G, c; size_t bstride;
    __device__ bool next(int i, Unit& u) const {
        const int L = i * G + c; if (L >= ntiles * nN) return false;
        const int mt = L / nN; const int v = tmap[mt]; u.pm = mt; u.pn = L - mt * nN; u.e = v >> 8; u.lt = v & 255; return true;
    }
    __device__ __forceinline__ const char* a_base(const Gemm& g, const Unit& u) const { return GA ? (const char*)g.A : (const char*)g.A + (size_t)u.pm * ((size_t)BM * g.K * 2); }
    __device__ __forceinline__ const char* b_base(const Gemm& g, const Unit& u) const { return (const char*)g.Bt + (size_t)u.e * bstride + (size_t)u.pn * ((size_t)BM * g.K * 2); }
    __device__ __forceinline__ int gidx(int ui, int r) const { return gtab[ui * 256 + r]; }
};

__device__ __forceinline__ unsigned cvt_pk_bf16(float lo, float hi) { return pk2(lo, hi); }

struct EpiBf16 {
    static constexpr bool PERM = true;
    bf16* O; int ldc;
    __device__ __forceinline__ void operator()(const f32x4 (&acc)[2][2][4][2], const Unit& u, int wr, int wc, int fr, int fq) const {
        const int row0 = u.pm * BM + wr * 64 + fr, col0 = u.pn * BM + wc * 32 + 8 * fq;
#pragma unroll
        for (int ai = 0; ai < 2; ++ai)
#pragma unroll
            for (int m = 0; m < 4; ++m) { bf16* rowp = O + (size_t)(row0 + ai * HALF + m * 16) * ldc + col0;
#pragma unroll
                for (int bj = 0; bj < 2; ++bj) { const f32x4 v0 = acc[ai][bj][m][0], v1 = acc[ai][bj][m][1];
                    v4u w; w.x = cvt_pk_bf16(v0[0], v0[1]); w.y = cvt_pk_bf16(v0[2], v0[3]); w.z = cvt_pk_bf16(v1[0], v1[1]); w.w = cvt_pk_bf16(v1[2], v1[3]);
                    *(v4u*)(rowp + bj * HALF) = w; } }
    }
};
struct EpiBf16Blk {
    static constexpr bool PERM = true;
    bf16* O; int M;
    __device__ __forceinline__ void operator()(const f32x4 (&acc)[2][2][4][2], const Unit& u, int wr, int wc, int fr, int fq) const {
        const int row0 = u.pm * BM + wr * 64 + fr, cin = wc * 32 + 8 * fq;
#pragma unroll
        for (int ai = 0; ai < 2; ++ai)
#pragma unroll
            for (int m = 0; m < 4; ++m) {
#pragma unroll
                for (int bj = 0; bj < 2; ++bj) { const f32x4 v0 = acc[ai][bj][m][0], v1 = acc[ai][bj][m][1];
                    v4u w; w.x = cvt_pk_bf16(v0[0], v0[1]); w.y = cvt_pk_bf16(v0[2], v0[3]); w.z = cvt_pk_bf16(v1[0], v1[1]); w.w = cvt_pk_bf16(v1[2], v1[3]);
                    *(v4u*)(O + ((size_t)(2 * u.pn + bj) * M + (row0 + ai * HALF + m * 16)) * 128 + cin) = w; } }
    }
};
struct EpiResF32 {
    static constexpr bool PERM = false;
    const float* res; float* out; int ldc;
    __device__ __forceinline__ void operator()(const f32x4 (&acc)[2][2][4][2], const Unit& u, int wr, int wc, int fr, int fq) const {
        const int row0 = u.pm * BM + wr * 64 + fr, col0 = u.pn * BM + wc * 32 + 4 * fq;
#pragma unroll
        for (int ai = 0; ai < 2; ++ai)
#pragma unroll
            for (int m = 0; m < 4; ++m) { const size_t off = (size_t)(row0 + ai * HALF + m * 16) * ldc + col0;
#pragma unroll
                for (int bj = 0; bj < 2; ++bj)
#pragma unroll
                    for (int n = 0; n < 2; ++n) { const f32x4 r = *(const f32x4*)(res + off + bj * HALF + n * 16); *(f32x4*)(out + off + bj * HALF + n * 16) = r + acc[ai][bj][m][n]; } }
    }
};
struct EpiSwiGlu {
    static constexpr bool PERM = true;
    bf16* H;
    __device__ __forceinline__ void operator()(const f32x4 (&acc)[2][2][4][2], const Unit& u, int wr, int wc, int fr, int fq) const {
        const int row0 = u.pm * BM + wr * 64 + fr, col0 = u.pn * 128 + wc * 32 + 8 * fq;
#pragma unroll
        for (int ai = 0; ai < 2; ++ai)
#pragma unroll
            for (int m = 0; m < 4; ++m) { bf16* rowp = H + (size_t)(row0 + ai * HALF + m * 16) * DEXP + col0;
                float o[8];
#pragma unroll
                for (int n = 0; n < 2; ++n)
#pragma unroll
                    for (int j = 0; j < 4; ++j) { const float g = acc[ai][0][m][n][j], up = acc[ai][1][m][n][j]; o[n * 4 + j] = (g * __builtin_amdgcn_rcpf(1.f + __expf(-g))) * up; }
                v4u w; w.x = cvt_pk_bf16(o[0], o[1]); w.y = cvt_pk_bf16(o[2], o[3]); w.z = cvt_pk_bf16(o[4], o[5]); w.w = cvt_pk_bf16(o[6], o[7]);
                *(v4u*)rowp = w; }
    }
};
struct EpiSwiGlu8 {
    static constexpr bool PERM = true;
    unsigned char* H;
    __device__ __forceinline__ void operator()(const f32x4 (&acc)[2][2][4][2], const Unit& u, int wr, int wc, int fr, int fq) const {
        const int row0 = u.pm * BM + wr * 64 + fr, col0 = u.pn * 128 + wc * 32 + 8 * fq;
#pragma unroll
        for (int ai = 0; ai < 2; ++ai)
#pragma unroll
            for (int m = 0; m < 4; ++m) { unsigned char* rowp = H + (size_t)(row0 + ai * HALF + m * 16) * DEXP + col0;
                float o[8];
#pragma unroll
                for (int n = 0; n < 2; ++n)
#pragma unroll
                    for (int j = 0; j < 4; ++j) { const float g = acc[ai][0][m][n][j], up = acc[ai][1][m][n][j]; o[n * 4 + j] = (g * __builtin_amdgcn_rcpf(1.f + __expf(-g))) * up; }
                int w0 = 0, w1 = 0;
                w0 = cvt2_fp8(o[0], o[1], w0, false); w0 = cvt2_fp8(o[2], o[3], w0, true);
                w1 = cvt2_fp8(o[4], o[5], w1, false); w1 = cvt2_fp8(o[6], o[7], w1, true);
                *(v2u*)rowp = (v2u){(unsigned)w0, (unsigned)w1}; }
    }
};
struct EpiScaleBf16 {
    static constexpr bool PERM = true;
    bf16* Y; int ldc; const float* wt; const LAS int* ecnt;
    __device__ __forceinline__ void operator()(const f32x4 (&acc)[2][2][4][2], const Unit& u, int wr, int wc, int fr, int fq) const {
        const int row0 = u.pm * BM + wr * 64 + fr, col0 = u.pn * BM + wc * 32 + 8 * fq;
        const int cnt = ecnt[u.e]; const float* wl = wt + (size_t)u.e * NTOK;
#pragma unroll
        for (int ai = 0; ai < 2; ++ai)
#pragma unroll
            for (int m = 0; m < 4; ++m) { const int lr = u.lt * 256 + wr * 64 + fr + ai * HALF + m * 16; const float s = lr < cnt ? wl[lr] : 0.f;
                bf16* rowp = Y + (size_t)(row0 + ai * HALF + m * 16) * ldc + col0;
#pragma unroll
                for (int bj = 0; bj < 2; ++bj) { const f32x4 v0 = acc[ai][bj][m][0] * s, v1 = acc[ai][bj][m][1] * s;
                    v4u w; w.x = cvt_pk_bf16(v0[0], v0[1]); w.y = cvt_pk_bf16(v0[2], v0[3]); w.z = cvt_pk_bf16(v1[0], v1[1]); w.w = cvt_pk_bf16(v1[2], v1[3]);
                    *(v4u*)(rowp + bj * HALF) = w; } }
    }
};

struct EpiScaleF8 {
    static constexpr bool PERM = true;
    unsigned char* Y; int ldc; const float* wt; const LAS int* ecnt;
    __device__ __forceinline__ void operator()(const f32x4 (&acc)[2][2][4][2], const Unit& u, int wr, int wc, int fr, int fq) const {
        const int row0 = u.pm * BM + wr * 64 + fr, col0 = u.pn * BM + wc * 32 + 8 * fq;
        const int cnt = ecnt[u.e]; const float* wl = wt + (size_t)u.e * NTOK;
#pragma unroll
        for (int ai = 0; ai < 2; ++ai)
#pragma unroll
            for (int m = 0; m < 4; ++m) { const int lr = u.lt * 256 + wr * 64 + fr + ai * HALF + m * 16; const float s = lr < cnt ? wl[lr] * 16.f : 0.f;
                unsigned char* rowp = Y + (size_t)(row0 + ai * HALF + m * 16) * ldc + col0;
#pragma unroll
                for (int bj = 0; bj < 2; ++bj) { const f32x4 v0 = acc[ai][bj][m][0] * s, v1 = acc[ai][bj][m][1] * s;
                    int w0 = 0, w1 = 0;
                    w0 = cvt2_fp8(v0[0], v0[1], w0, false); w0 = cvt2_fp8(v0[2], v0[3], w0, true);
                    w1 = cvt2_fp8(v1[0], v1[1], w1, false); w1 = cvt2_fp8(v1[2], v1[3], w1, true);
                    *(v2u*)(rowp + bj * HALF) = (v2u){(unsigned)w0, (unsigned)w1}; } }
    }
};

template <class Epi, class Sched, bool ALIGN_EPI, bool FP8 = false>
__device__ __forceinline__ void gemm_phase(LAS unsigned char* lds, const Gemm g, const Sched& S, const Epi& E) {
    constexpr bool GA = Sched::GATHER;
    int tid_ = threadIdx.x; asm volatile("" : "+v"(tid_));
    const int tid = tid_, wid = __builtin_amdgcn_readfirstlane(tid >> 6), lane = tid & 63, wr = wid >> 2, wc = wid & 3, fr = lane & 15, fq = lane >> 4;
    const int K = g.K, nt = K / BK;
    unsigned voffA[2], voffB[2], gC[2]; int gR[2];
#pragma unroll
    for (int i = 0; i < 2; ++i) { int R, C; stage_rc(tid * 16 + i * 8192, R, C); const int Rb = Epi::PERM ? ((R & ~31) + perm32(R & 31)) : R;
        voffA[i] = (unsigned)(R * K + C) * 2u; voffB[i] = (unsigned)(Rb * K + C) * 2u; gR[i] = R; gC[i] = (unsigned)C * 2u; }
    const size_t kstep = (size_t)(BK * 2);
    const size_t hstep = (size_t)HALF * K * 2;
    const size_t H1 = GA ? 0 : hstep;
    const unsigned ldsw = (unsigned)wid * 1024u;
    const int aoff = lds_byte(wr * 64 + fr, fq * 8), boff = lds_byte(wc * 32 + fr, fq * 8);
    unsigned vA0[2], vA1[2], vT1[2];
#define PG8_LOADG(ui_) do { int tg_ = threadIdx.x; asm volatile("" : "+v"(tg_)); _Pragma("unroll") for (int _i = 0; _i < 2; ++_i) { int R_, C_; stage_rc(tg_ * 16 + _i * 8192, R_, C_); vA0[_i] = (unsigned)S.gidx((ui_), R_) * (unsigned)(K * 2) + (unsigned)C_ * 2u; vA1[_i] = (unsigned)S.gidx((ui_), HALF + R_) * (unsigned)(K * 2) + (unsigned)C_ * 2u; } } while (0)
    unsigned (&rA0)[2] = GA ? vA0 : voffA; unsigned (&rA1)[2] = GA ? vA1 : voffA; unsigned (&rT1)[2] = GA ? vT1 : voffA;
#define PG8_SA(b, h) (((b) * 2 + (h)) * HTB)
#define PG8_SB(b, h) ((4 + (b) * 2 + (h)) * HTB)
#define PG8_STAGE(bufoff, gbase, voff) do { unsigned long long gb_ = (unsigned long long)(gbase); asm volatile("" : "+s"(gb_));     \
        _Pragma("unroll") for (int _i = 0; _i < 2; ++_i) { unsigned vo_ = (voff)[_i]; asm volatile("" : "+v"(vo_));     \
        __builtin_amdgcn_global_load_lds((const unsigned*)((const char*)gb_ + vo_), (LAS unsigned*)(lds + (bufoff) + ldsw + _i * 8192), 16, 0, 0); } } while (0)
#define PG8_LDA(dst, b, h) do { _Pragma("unroll") for (int m = 0; m < 4; ++m) { if constexpr (FP8) { \
            dst##8[m].lo = *(const LAS v4i_*)(lds + PG8_SA(b, h) + aoff + m * 2048); dst##8[m].hi = *(const LAS v4i_*)(lds + PG8_SA(b, h) + aoff + m * 2048 + 1024); } \
        else { _Pragma("unroll") for (int k = 0; k < 2; ++k) dst[m][k] = *(const LAS bf16x8*)(lds + PG8_SA(b, h) + aoff + m * 2048 + k * 1024); } } } while (0)
#define PG8_LDB(dst, b, h) do { _Pragma("unroll") for (int n = 0; n < 2; ++n) { if constexpr (FP8) { \
            dst##8[n].lo = *(const LAS v4i_*)(lds + PG8_SB(b, h) + boff + n * 2048); dst##8[n].hi = *(const LAS v4i_*)(lds + PG8_SB(b, h) + boff + n * 2048 + 1024); } \
        else { _Pragma("unroll") for (int k = 0; k < 2; ++k) dst[n][k] = *(const LAS bf16x8*)(lds + PG8_SB(b, h) + boff + n * 2048 + k * 1024); } } } while (0)
#define PG8_MMA(ai, bj, At, Bt) do { __builtin_amdgcn_s_setprio(1); _Pragma("unroll") for (int m = 0; m < 4; ++m) _Pragma("unroll") for (int n = 0; n < 2; ++n) { \
        if constexpr (FP8) asm volatile("v_mfma_scale_f32_16x16x128_f8f6f4 %0, %1, %2, %0, %3, %4 op_sel_hi:[0,0,0]" : "+v"(acc[ai][bj][m][n]) : "v"(Bt##8[n]), "v"(At##8[m]), "v"(wsc_), "v"(one_));     \
        else { _Pragma("unroll") for (int k = 0; k < 2; ++k) acc[ai][bj][m][n] = __builtin_amdgcn_mfma_f32_16x16x32_bf16(Bt[n][k], At[m][k], acc[ai][bj][m][n], 0, 0, 0); } } \
        __builtin_amdgcn_s_setprio(0); } while (0)
#define PG8_WAIT_V(n) asm volatile("s_waitcnt vmcnt(" #n ")" ::: "memory")
#define PG8_WAIT_L(n) asm volatile("s_waitcnt lgkmcnt(" #n ")" ::: "memory")
#define PG8_BAR __builtin_amdgcn_s_barrier()
#define PG8_SCHED __builtin_amdgcn_sched_barrier(0)
    Unit cur, nxt; int ui = 0;
    if (!S.next(0, cur)) return;
    f32x4 acc[2][2][4][2];
#pragma unroll
    for (int a = 0; a < 2; ++a)
#pragma unroll
        for (int b = 0; b < 2; ++b)
#pragma unroll
            for (int m = 0; m < 4; ++m)
#pragma unroll
                for (int n = 0; n < 2; ++n) acc[a][b][m][n] = (f32x4){0.f, 0.f, 0.f, 0.f};
    typedef int v8i_ __attribute__((ext_vector_type(8))); typedef int v4i_ __attribute__((ext_vector_type(4)));
    const int wsc_ = (int)g.wscale, one_ = 0x7f7f7f7f;
    bf16x8 At[4][2], B0[2][2], B1[2][2]; v8i_ At8[4], B08[2], B18[2];
    const char* cA = S.a_base(g, cur); const char* cB = S.b_base(g, cur);
    if constexpr (GA) { PG8_LOADG(0); vT1[0] = vA1[0]; vT1[1] = vA1[1]; }
    PG8_STAGE(PG8_SB(0, 0), cB, voffB); PG8_STAGE(PG8_SB(0, 1), cB + hstep, voffB); PG8_STAGE(PG8_SA(0, 0), cA, rA0); PG8_STAGE(PG8_SA(0, 1), cA + H1, rA1);
    if (wr == 1) PG8_BAR;
    PG8_WAIT_V(2); PG8_BAR;
    PG8_STAGE(PG8_SB(1, 0), cB + kstep, voffB); PG8_STAGE(PG8_SA(1, 0), cA + kstep, rA0); PG8_STAGE(PG8_SB(1, 1), cB + hstep + kstep, voffB);
    PG8_WAIT_V(6); PG8_BAR;
    for (;;) {
        const bool has_next = S.next(ui + 1, nxt);
        const char* nA = has_next ? S.a_base(g, nxt) : cA; const char* nB = has_next ? S.b_base(g, nxt) : cB;
#pragma unroll 1
        for (int t = 0; t < nt; t += 2) {
            const bool last = (t == nt - 2);
            const char* a1 = cA + (size_t)(t + 1) * kstep;
            const char* a2 = last ? nA : cA + (size_t)(t + 2) * kstep; const char* b2 = last ? nB : cB + (size_t)(t + 2) * kstep;
            const char* a3 = a2 + kstep; const char* b3 = b2 + kstep;
            if constexpr (GA) { if (last && has_next) PG8_LOADG(ui + 1); }
            PG8_LDB(B0, 0, 0); PG8_LDB(B1, 0, 1); PG8_SCHED; PG8_LDA(At, 0, 0); PG8_STAGE(PG8_SA(1, 1), a1 + H1, rT1);
            PG8_WAIT_V(8); PG8_WAIT_L(0); PG8_BAR; PG8_MMA(0, 0, At, B0); PG8_MMA(0, 1, At, B1); PG8_BAR; PG8_SCHED;
            PG8_LDA(At, 0, 1); PG8_STAGE(PG8_SB(0, 0), b2, voffB); PG8_STAGE(PG8_SB(0, 1), b2 + hstep, voffB); PG8_STAGE(PG8_SA(0, 0), a2, rA0);
            PG8_WAIT_V(8); PG8_WAIT_L(0); PG8_BAR; PG8_MMA(1, 0, At, B0); PG8_MMA(1, 1, At, B1); PG8_BAR; PG8_SCHED;
            PG8_LDB(B0, 1, 0); PG8_LDB(B1, 1, 1); PG8_SCHED; PG8_LDA(At, 1, 0); PG8_STAGE(PG8_SA(0, 1), a2 + H1, rA1);
            PG8_WAIT_V(8); PG8_WAIT_L(0); PG8_BAR; PG8_MMA(0, 0, At, B0); PG8_MMA(0, 1, At, B1); PG8_BAR; PG8_SCHED;
            PG8_LDA(At, 1, 1); PG8_STAGE(PG8_SB(1, 0), b3, voffB); PG8_STAGE(PG8_SB(1, 1), b3 + hstep, voffB); PG8_STAGE(PG8_SA(1, 0), a3, rA0);
            PG8_WAIT_V(8); PG8_WAIT_L(0); PG8_BAR; PG8_MMA(1, 0, At, B0); PG8_MMA(1, 1, At, B1); PG8_BAR; PG8_SCHED;
        }
        if constexpr (FP8) asm volatile("s_nop 15\n\ts_nop 15" ::: "memory");
        if constexpr (ALIGN_EPI) { if (wr == 0) PG8_BAR; }
        E(acc, cur, wr, wc, fr, fq);
        if (!has_next) break;
#pragma unroll
        for (int a = 0; a < 2; ++a)
#pragma unroll
            for (int b = 0; b < 2; ++b)
#pragma unroll
                for (int m = 0; m < 4; ++m)
#pragma unroll
                    for (int n = 0; n < 2; ++n) acc[a][b][m][n] = (f32x4){0.f, 0.f, 0.f, 0.f};
        cur = nxt; cA = nA; cB = nB; ++ui;
        if constexpr (GA) { vT1[0] = vA1[0]; vT1[1] = vA1[1]; }
        if constexpr (ALIGN_EPI) { if (wr == 1) PG8_BAR; }
    }
    PG8_WAIT_V(0);
    if constexpr (!ALIGN_EPI) { if (wr == 0) PG8_BAR; }
    PG8_BAR;
#undef PG8_LOADG
#undef PG8_SA
#undef PG8_SB
#undef PG8_STAGE
#undef PG8_LDA
#undef PG8_LDB
#undef PG8_MMA
#undef PG8_WAIT_V
#undef PG8_WAIT_L
#undef PG8_BAR
#undef PG8_SCHED
}
}

constexpr size_t MiB = 1u << 20;
constexpr size_t WS_CTL = 0, CTL_ZERO_BYTES = 1 * MiB;
constexpr size_t SZ_WIN = (size_t)NP * DM * 2, SZ_WDT = (size_t)16 * DM * 2, SZ_WR = (size_t)48 * DM * 2, SZ_WOUT = (size_t)DM * DM * 2;
constexpr size_t SZ_WGU1 = (size_t)1024 * DM * 2, SZ_WD1 = (size_t)DM * DEXP * 2;
constexpr size_t WS_WIN = 1 * MiB;
constexpr size_t WS_WDT = WS_WIN + NLAYER * SZ_WIN;
constexpr size_t WS_WR = WS_WDT + NLAYER * SZ_WDT;
constexpr size_t WS_WOUT = WS_WR + NLAYER * SZ_WR;
constexpr size_t WS_WGU = WS_WOUT + NLAYER * SZ_WOUT;
constexpr size_t WS_WD = WS_WGU + NLAYER * NEXP * SZ_WGU1;
constexpr size_t WS_P = WS_WD + NLAYER * NEXP * SZ_WD1;
constexpr size_t SZ_P = (size_t)NTOK * NP * 2;
constexpr size_t WS_Y = WS_P, SZ_Y = (size_t)PADROWS * DM * 2;
constexpr size_t WS_HID = WS_Y + SZ_Y, SZ_HID = (size_t)PADROWS * DEXP * 2;
static_assert(SZ_Y + SZ_HID <= SZ_P, "Y|HID overlay P");
constexpr size_t WS_U = WS_P + SZ_P, SZ_U = (size_t)NTOK * DM * 2;
constexpr size_t WS_DT = WS_U + SZ_U, SZ_DT = (size_t)NTOK * 16 * 4;
constexpr size_t WS_TOK = WS_DT + SZ_DT, SZ_TOK = (size_t)NEXP * NTOK * 4;
constexpr size_t WS_WT = WS_TOK + SZ_TOK;
constexpr size_t WS_SLOT = WS_WT + SZ_TOK, SZ_SLOT = (size_t)NTOK * 2 * 4;
constexpr size_t WS_ROT = WS_SLOT + SZ_SLOT, SZ_ROT = (size_t)SEQ * 64 * 4;
constexpr size_t WS_XC = WS_ROT + 2 * SZ_ROT, SZ_XC = (size_t)NTOK * CONVD * 2;
constexpr size_t HPU = 16384 + 16384 + 8192 + 512;
constexpr size_t WS_HP = WS_XC + SZ_XC, SZ_HP = (size_t)32 * 32 * HPU;
constexpr size_t WS_U8 = WS_XC;
constexpr size_t WS_SD = WS_HP + SZ_HP, SZ_SD = (size_t)8 * 16 * SEQ * 16;
constexpr size_t WS_END = WS_SD + SZ_SD;
static_assert(WS_END < 1000000000ull, "workspace map");
constexpr int CW_BAR = 4096;
constexpr int CW_CNT = 8192;
constexpr int RING_BYTES = 131072, LDSCTL_OFF = RING_BYTES, MISC_OFF = LDSCTL_OFF + 320;
constexpr int TAB_OFF = RING_BYTES + 1024;
constexpr int T_TMAP = 0, T_ECNT = 192, T_EBASE = 224, T_GTAB = 256, T_END = 256 + 1024;
constexpr int LDS_BYTES = 147456;
static_assert(TAB_OFF + T_END * 4 <= LDS_BYTES, "LDS map");
constexpr int NWAVES = 8;

#define XB_TMO      128
#define XB_XCNT(j)  (256  + 64 * (j))
#define XB_XSUB(j)  (1280 + 64 * (j))
#define XB_XGEN(j)  (2304 + 64 * (j))
#define XB_TOP      3328
#define XB_TOPGEN   3392
#define XCD_BAR_WORDS 3456
#define XB_SPIN_CAP (1u << 18)
__device__ __forceinline__ unsigned xb_ld(unsigned* p)              { return __hip_atomic_load(p, __ATOMIC_RELAXED, __HIP_MEMORY_SCOPE_AGENT); }
__device__ __forceinline__ unsigned xb_add(unsigned* p, unsigned v) { return __hip_atomic_fetch_add(p, v, __ATOMIC_RELAXED, __HIP_MEMORY_SCOPE_AGENT); }
__device__ __forceinline__ unsigned xb_xcc_id() { return (unsigned)__builtin_amdgcn_s_getreg((3 << 11) | 20) & 0xFu; }
#define XB_SPIN(cond, bar) do { unsigned _sp = 0; while (cond) { __builtin_amdgcn_s_sleep(1); \
    if ((++_sp & 255u) == 0u) { if (xb_ld(&(bar)[XB_TMO])) break; if (_sp > XB_SPIN_CAP) { atomicAdd(&(bar)[XB_TMO], 1u); break; } } } } while (0)
struct XcdBarrier { unsigned* bar; unsigned x; volatile LAS unsigned* st; };
__device__ __forceinline__ XcdBarrier xcd_barrier_post(unsigned* bar, volatile LAS unsigned* st) {
    XcdBarrier b; b.bar = bar; b.x = xb_xcc_id(); b.st = st;
    if (threadIdx.x == 0) (void)xb_add(&bar[XB_XCNT(b.x)], 1u);
    return b;
}
__device__ __forceinline__ void xcd_barrier_complete(unsigned* bar, unsigned x, unsigned& nloc, unsigned& nx) {
    const unsigned G = gridDim.x * gridDim.y * gridDim.z;
    unsigned sum, cnt, mine, sp = 0u;
    for (;;) {
        sum = 0u; cnt = 0u; mine = 0u;
#pragma unroll
        for (unsigned j = 0; j < 16; ++j) { const unsigned c = xb_ld(&bar[XB_XCNT(j)]); sum += c; cnt += (c > 0u) ? 1u : 0u; mine = (j == x) ? c : mine; }
        if (sum == G) break;
        __builtin_amdgcn_s_sleep(1);
        if ((++sp & 255u) == 0u) { if (xb_ld(&bar[XB_TMO])) break; if (sp > XB_SPIN_CAP) { atomicAdd(&bar[XB_TMO], 1u); break; } }
    }
    nloc = mine > 0u ? mine : 1u; nx = cnt > 0u ? cnt : 1u;
}
__device__ __forceinline__ void xcd_barrier(const XcdBarrier& b) {
    asm volatile("s_waitcnt vmcnt(0)" ::: "memory");
    __syncthreads();
    if (threadIdx.x == 0) {
        unsigned* bar = b.bar;
        __builtin_amdgcn_s_waitcnt(0);
        unsigned nloc = b.st[0], nx = b.st[1];
        if (nloc == 0u) { xcd_barrier_complete(bar, b.x, nloc, nx); b.st[0] = nloc; b.st[1] = nx; }
        const unsigned old = xb_add(&bar[XB_XSUB(b.x)], 1u);
        const unsigned gen = old / nloc;
        if (old + 1u == (gen + 1u) * nloc) {
            __builtin_amdgcn_fence(__ATOMIC_RELEASE, "agent");
            asm volatile("s_waitcnt vmcnt(0)" ::: "memory");
            const unsigned og = xb_add(&bar[XB_TOP], 1u);
            const unsigned tg = og / nx;
            if (og + 1u == (tg + 1u) * nx) xb_add(&bar[XB_TOPGEN], 1u);
            else XB_SPIN(xb_ld(&bar[XB_TOPGEN]) == tg, bar);
            __builtin_amdgcn_fence(__ATOMIC_ACQUIRE, "agent");
            xb_add(&bar[XB_XGEN(b.x)], 1u);
            asm volatile("s_waitcnt vmcnt(0)" ::: "memory");
        } else {
            XB_SPIN(xb_ld(&bar[XB_XGEN(b.x)]) == gen, bar);
            __builtin_amdgcn_fence(__ATOMIC_ACQUIRE, "agent");
            asm volatile("s_waitcnt vmcnt(0)" ::: "memory");
        }
    }
    __syncthreads();
}

struct Args { const float* in[21]; float* out; unsigned char* ws; int gp_lo, gp_hi; };
struct Frame {
    LAS unsigned char* lds;
    volatile LAS unsigned* MISC;
    LAS int* tab;
    unsigned* ctl;
    int tid, lane, wave, G, bid;
    float* out; unsigned char* ws;
};
enum { I_X = 0, I_ANW, I_WIN, I_CONVW, I_CONVB, I_DTB, I_ALOG, I_SSDD, I_SSDNW, I_HLB, I_HNW, I_WOUT, I_FNW, I_RGW, I_RGB, I_REW, I_REB, I_EWG, I_EWU, I_EWD, I_FINW };

__device__ __forceinline__ int gt0(const Frame& F) { return F.bid * (NWAVES * 64) + F.tid; }
struct TItem { const float* W; bf16* base; int N, K, kind, up, k0, n0; float sc; };
__device__ __forceinline__ bf16* titem_row(const TItem& t, int n) {
    if (n >= t.N) return nullptr;
    if (t.kind == 0) { if (n < DT_COL0) return t.base + (size_t)n * DM; if (n < DT_COL0 + 16) return nullptr; return t.base + (size_t)(n - 16) * DM; }
    if (t.kind == 1) return t.base + (size_t)n * t.K;
    return t.base + (size_t)((n >> 7) * 256 + t.up * 128 + (n & 127)) * DM;
}
constexpr int TI_IN = 32 * 209, TI_OUT = 32 * 64, TI_G = 32 * 16, TI_D = 8 * 64, TI_LAYER = TI_IN + TI_OUT + NEXP * (2 * TI_G + TI_D);
__device__ __forceinline__ void titem_decode(const Frame& F, const Args& A, int it, TItem& t) {
    const int l = it / TI_LAYER; int r = it - l * TI_LAYER; t.up = 0; t.sc = 1.f;
    if (r < TI_IN) { t.W = A.in[I_WIN] + (size_t)l * DM * IN_DIM; t.base = (bf16*)(F.ws + WS_WIN + l * SZ_WIN); t.N = IN_DIM; t.K = DM; t.kind = 0; }
    else if ((r -= TI_IN) < TI_OUT) { t.W = A.in[I_WOUT] + (size_t)l * DM * DM; t.base = (bf16*)(F.ws + WS_WOUT + l * SZ_WOUT); t.N = DM; t.K = DM; t.kind = 1; }
    else { r -= TI_OUT; const int e = r / (2 * TI_G + TI_D); r -= e * (2 * TI_G + TI_D); const size_t eo = (size_t)(l * NEXP + e);
        if (r < TI_G) { t.W = A.in[I_EWG] + eo * DM * DEXP; t.base = (bf16*)(F.ws + WS_WGU + eo * SZ_WGU1); t.N = DEXP; t.K = DM; t.kind = MOE_FP8 ? 3 : 2; t.sc = 64.f; }
        else if ((r -= TI_G) < TI_G) { t.W = A.in[I_EWU] + eo * DM * DEXP; t.base = (bf16*)(F.ws + WS_WGU + eo * SZ_WGU1); t.N = DEXP; t.K = DM; t.kind = MOE_FP8 ? 3 : 2; t.up = 1; t.sc = 64.f; }
        else { r -= TI_G; t.W = A.in[I_EWD] + eo * DEXP * DM; t.base = (bf16*)(F.ws + WS_WD + eo * SZ_WD1); t.N = DM; t.K = DEXP; t.kind = MOE_FP8 ? 4 : 1; t.sc = 32.f; } }
    const int nblk = (t.N + 31) / 32, kb = r / nblk, nb = r - kb * nblk; t.k0 = 64 * kb; t.n0 = 32 * nb;
}
__device__ __forceinline__ void titem_load(const TItem& t, f32x4 (&v)[8], int lane) {
    const int kq = lane >> 3, nc = t.n0 + 4 * (lane & 7); const bool ok = nc < t.N;
#pragma unroll
    for (int j = 0; j < 8; ++j) v[j] = ok ? *(const f32x4*)(t.W + (size_t)(t.k0 + kq + 8 * j) * t.N + nc) : (f32x4){0.f, 0.f, 0.f, 0.f};
}
__device__ __forceinline__ void titem_store(const TItem& t, const f32x4 (&v)[8], LAS float* scr, int lane) {
    const int kq = lane >> 3, c4 = lane & 7;
#pragma unroll
    for (int j = 0; j < 8; ++j)
#pragma unroll
        for (int e = 0; e < 4; ++e) scr[(kq + 8 * j) * 33 + 4 * c4 + e] = v[j][e];
    LDS_WAIT(); asm volatile("" ::: "memory");
    if (t.kind >= 3) {
        const int n = lane & 31, hf = lane >> 5; const LAS float* s = scr + (32 * hf) * 33 + n; v4u o[2];
#pragma unroll
        for (int q = 0; q < 8; ++q) { int w_ = 0;
            w_ = cvt2_fp8(s[(4 * q + 0) * 33] * t.sc, s[(4 * q + 1) * 33] * t.sc, w_, false);
            w_ = cvt2_fp8(s[(4 * q + 2) * 33] * t.sc, s[(4 * q + 3) * 33] * t.sc, w_, true);
            o[q >> 2][q & 3] = (unsigned)w_; }
        const int nn = t.n0 + n;
        if (nn < t.N) { unsigned char* dst = (unsigned char*)t.base + (t.kind == 3 ? (size_t)((nn >> 7) * 256 + t.up * 128 + (nn & 127)) * DM : (size_t)nn * t.K) + t.k0 + 32 * hf;
            *(v4u*)dst = o[0]; *(v4u*)(dst + 16) = o[1]; }
        LDS_WAIT(); asm volatile("" ::: "memory");
        return;
    }
    const int c = lane & 7;
#pragma unroll
    for (int j = 0; j < 4; ++j) { const int n = (lane >> 3) + 8 * j; const LAS float* s = scr + (8 * c) * 33 + n;
        v4u o; o.x = pk2(s[0 * 33], s[1 * 33]); o.y = pk2(s[2 * 33], s[3 * 33]); o.z = pk2(s[4 * 33], s[5 * 33]); o.w = pk2(s[6 * 33], s[7 * 33]);
        bf16* dst = titem_row(t, t.n0 + n); if (dst) *(v4u*)(dst + t.k0 + 8 * c) = o; }
    LDS_WAIT(); asm volatile("" ::: "memory");
}
#ifndef CONV_SPLIT_ITEMS
#define CONV_SPLIT_ITEMS 20000
#endif
constexpr int CONV_SPLIT = CONV_SPLIT_ITEMS;
#ifndef CT_ITEMS
#define CT_ITEMS 20000
#endif
constexpr int CT_LO = NLAYER * (32 * 209 + 32 * 64 + NEXP * (2 * 32 * 16 + 8 * 64)) - CT_ITEMS;
constexpr int G1_WGS = 192;
static_assert(CONV_SPLIT >= TI_IN && CONV_SPLIT <= NLAYER * TI_LAYER, "conversion split");
__device__ __forceinline__ void convert_items(Frame& F, const Args& A, int lo, int hi, int gw, int NGW) {
    LAS float* scr = (LAS float*)(F.lds + F.wave * 16384);
    for (int it = lo + gw; it < hi; it += 4 * NGW) {
        TItem t0, t1, t2, t3; f32x4 v0[8], v1[8], v2[8], v3[8];
        const bool h1 = it + NGW < hi, h2 = it + 2 * NGW < hi, h3 = it + 3 * NGW < hi;
        titem_decode(F, A, it, t0); titem_load(t0, v0, F.lane);
        if (h1) { titem_decode(F, A, it + NGW, t1); titem_load(t1, v1, F.lane); }
        if (h2) { titem_decode(F, A, it + 2 * NGW, t2); titem_load(t2, v2, F.lane); }
        if (h3) { titem_decode(F, A, it + 3 * NGW, t3); titem_load(t3, v3, F.lane); }
        titem_store(t0, v0, scr, F.lane);
        if (h1) titem_store(t1, v1, scr, F.lane);
        if (h2) titem_store(t2, v2, scr, F.lane);
        if (h3) titem_store(t3, v3, scr, F.lane);
    }
}
__device__ __forceinline__ void phase_prologue(Frame& F, const Args& A) {
    const int gw = F.bid * NWAVES + F.wave, NGW = F.G * NWAVES;
    convert_items(F, A, 0, CONV_SPLIT, gw, NGW);
    for (int i = gt0(F); i < SEQ * 64; i += F.G * NWAVES * 64) { const int pos = i >> 6, ri = i & 63; float sn, cs; sincosf((float)pos * powf(10000.f, -(float)ri / 64.f), &sn, &cs);
        ((float*)(F.ws + WS_ROT))[i] = cs; ((float*)(F.ws + WS_ROT + SZ_ROT))[i] = sn; }
    const int gt = F.bid * (NWAVES * 64) + F.tid, NGT = F.G * NWAVES * 64;
    for (int i = gt; i < NLAYER * 16 * DM; i += NGT) { const int l = i / (16 * DM), j = (i / DM) % 16, k = i % DM;
        ((bf16*)(F.ws + WS_WDT))[i] = (bf16)f2bf(A.in[I_WIN][(size_t)l * DM * IN_DIM + (size_t)k * IN_DIM + DT_COL0 + j]); }
    for (int i = gt; i < NLAYER * 48 * DM; i += NGT) { const int l = i / (48 * DM), j = (i / DM) % 48, k = i % DM;
        float v = 0.f; if (j < 4) v = A.in[I_RGW][((size_t)l * DM + k) * 4 + j]; else if (j < 36) v = A.in[I_REW][((size_t)l * DM + k) * 32 + (j - 4)];
        ((bf16*)(F.ws + WS_WR))[i] = (bf16)f2bf(v); }
}

template <int NCT>
__device__ __forceinline__ void mini_gemm16(const bf16* A, const bf16* Bt, f32x4 (&acc)[NCT], int lane, int ks0, int ks1) {
    const int fr = lane & 15, fq = lane >> 4;
#pragma unroll
    for (int c = 0; c < NCT; ++c) acc[c] = (f32x4){0.f, 0.f, 0.f, 0.f};
    const bf16* ap = A + (size_t)fr * DM + fq * 8; const bf16* bp = Bt + (size_t)fr * DM + fq * 8;
#pragma unroll 8
    for (int ks = ks0; ks < ks1; ++ks) {
        const bf16x8 a = *(const bf16x8*)(ap + ks * 32);
#pragma unroll
        for (int c = 0; c < NCT; ++c) { const bf16x8 b = *(const bf16x8*)(bp + (size_t)c * 16 * DM + ks * 32); acc[c] = __builtin_amdgcn_mfma_f32_16x16x32_bf16(a, b, acc[c], 0, 0, 0); }
    }
}

__device__ __forceinline__ void build_tables(Frame& F, int l) {
    if (F.tid == 0) { int run = 0;
        for (int e = 0; e < NEXP; ++e) { const int c = (int)__hip_atomic_load(F.ctl + CW_CNT + (l * NEXP + e) * 64, RLX_AGENT); const int nt = (c + 255) >> 8;
            F.tab[T_ECNT + e] = c; F.tab[T_EBASE + e] = run; for (int t = 0; t < nt; ++t) F.tab[T_TMAP + run + t] = (e << 8) | t; run += nt; }
        F.MISC[16] = (unsigned)run; }
    __syncthreads();
}

template <int MODE, int NR, bool F8 = false>
__device__ __forceinline__ void norm_rows(const float* const (&src)[NR], float* const (&hdst)[NR], const bf16* const (&y0)[NR], const bf16* const (&y1)[NR], const f32x4 (&wv)[8], bf16* const (&udst)[NR], float* const (&fdst)[NR], int lane, unsigned char* const* u8 = nullptr) {
    f32x4 v[NR][8];
#pragma unroll
    for (int q = 0; q < NR; ++q)
#pragma unroll
        for (int j = 0; j < 8; ++j) v[q][j] = ((const f32x4*)src[q] + lane)[64 * j];
    if (MODE >= 1) {
#pragma unroll
        for (int q = 0; q < NR; ++q) {
#if MOE_FP8
            unsigned ya[8], yb[8];
#pragma unroll
            for (int j = 0; j < 8; ++j) { ya[j] = *((const unsigned*)y0[q] + lane + 64 * j); yb[j] = *((const unsigned*)y1[q] + lane + 64 * j); }
#pragma unroll
            for (int j = 0; j < 8; ++j) { const f32x2 a0 = __builtin_amdgcn_cvt_pk_f32_fp8((int)ya[j], false), a1 = __builtin_amdgcn_cvt_pk_f32_fp8((int)ya[j], true), b0 = __builtin_amdgcn_cvt_pk_f32_fp8((int)yb[j], false), b1 = __builtin_amdgcn_cvt_pk_f32_fp8((int)yb[j], true);
                v[q][j][0] += (a0.x + b0.x) * 0.0625f; v[q][j][1] += (a0.y + b0.y) * 0.0625f; v[q][j][2] += (a1.x + b1.x) * 0.0625f; v[q][j][3] += (a1.y + b1.y) * 0.0625f; }
#else
            v2u ya[8], yb[8];
#pragma unroll
            for (int j = 0; j < 8; ++j) { ya[j] = *((const v2u*)y0[q] + lane + 64 * j); yb[j] = *((const v2u*)y1[q] + lane + 64 * j); }
#pragma unroll
            for (int j = 0; j < 8; ++j) { const v2u a = ya[j], b = yb[j];
                v[q][j][0] += __uint_as_float(a.x << 16) + __uint_as_float(b.x << 16); v[q][j][1] += __uint_as_float(a.x & 0xffff0000u) + __uint_as_float(b.x & 0xffff0000u);
                v[q][j][2] += __uint_as_float(a.y << 16) + __uint_as_float(b.y << 16); v[q][j][3] += __uint_as_float(a.y & 0xffff0000u) + __uint_as_float(b.y & 0xffff0000u); }
#endif
        }
    }
#pragma unroll
    for (int q = 0; q < NR; ++q) {
        if (MODE == 1) {
#pragma unroll
            for (int j = 0; j < 8; ++j) ((f32x4*)hdst[q] + lane)[64 * j] = v[q][j];
        }
        float s = 0.f;
#pragma unroll
        for (int j = 0; j < 8; ++j) s += (v[q][j][0] * v[q][j][0] + v[q][j][1] * v[q][j][1]) + (v[q][j][2] * v[q][j][2] + v[q][j][3] * v[q][j][3]);
        const float rstd = 1.f / sqrtf(wave_sum(s) * (1.f / DM) + EPS);
#pragma unroll
        for (int j = 0; j < 8; ++j) { const f32x4 o = v[q][j] * rstd * wv[j];
            if (MODE == 2) ((f32x4*)fdst[q] + lane)[64 * j] = o;
            else { v2u p; p.x = pk2(o[0], o[1]); p.y = pk2(o[2], o[3]); ((v2u*)udst[q] + lane)[64 * j] = p;
                if constexpr (F8) { int w_ = 0; w_ = cvt2_fp8(o[0], o[1], w_, false); w_ = cvt2_fp8(o[2], o[3], w_, true); ((unsigned*)u8[q] + lane)[64 * j] = (unsigned)w_; } } }
    }
}
__device__ __forceinline__ void load_normw(const float* w, f32x4 (&wv)[8], int lane) {
#pragma unroll
    for (int j = 0; j < 8; ++j) wv[j] = ((const f32x4*)w + lane)[64 * j];
}

__device__ __forceinline__ void phase_norm1(Frame& F, const Args& A, int l) {
    bf16* U = (bf16*)(F.ws + WS_U); const bf16* Y = (const bf16*)(F.ws + WS_Y); const int* slot = (const int*)(F.ws + WS_SLOT);
    f32x4 wv[8]; load_normw(A.in[I_ANW] + l * DM, wv, F.lane);
    if (l > 0) build_tables(F, l - 1);
    for (int blk = F.bid; blk < NTOK / 64; blk += F.G) {
        const int row0 = blk * 64;
        for (int r = 0; r < 8; r += 2) { const int row = row0 + F.wave * 8 + r;
            const float* src[2]; float* hd[2]; const bf16* ya[2]; const bf16* yb[2]; bf16* ud[2]; float* fd[2] = {nullptr, nullptr};
#pragma unroll
            for (int q = 0; q < 2; ++q) { const int rw = row + q; ud[q] = U + (size_t)rw * DM;
                if (l == 0) { src[q] = A.in[I_X] + (size_t)rw * DM; hd[q] = nullptr; ya[q] = nullptr; yb[q] = nullptr; }
                else { const int s0 = slot[rw * 2], s1 = slot[rw * 2 + 1];
                    ya[q] = Y + ((size_t)F.tab[T_EBASE + (s0 >> 16)] * 256 + (s0 & 0xffff)) * (MOE_FP8 ? DM / 2 : DM); yb[q] = Y + ((size_t)F.tab[T_EBASE + (s1 >> 16)] * 256 + (s1 & 0xffff)) * (MOE_FP8 ? DM / 2 : DM);
                    src[q] = F.out + (size_t)rw * DM; hd[q] = F.out + (size_t)rw * DM; } }
            if (l == 0) norm_rows<0, 2>(src, hd, ya, yb, wv, ud, fd, F.lane); else norm_rows<1, 2>(src, hd, ya, yb, wv, ud, fd, F.lane);
        }
        VM_WAIT(); __syncthreads();
        { f32x4 acc[1]; const int rt = F.wave & 3, kh = F.wave >> 2, rb = row0 + rt * 16;
            mini_gemm16<1>(U + (size_t)rb * DM, (const bf16*)(F.ws + WS_WDT + l * SZ_WDT), acc, F.lane, kh * 32, kh * 32 + 32);
            LAS f32x4* part = (LAS f32x4*)F.lds;
            if (kh == 1) part[rt * 64 + F.lane] = acc[0];
            __syncthreads();
            if (kh == 0) { const f32x4 t = acc[0] + part[rt * 64 + F.lane]; float* DT = (float*)(F.ws + WS_DT);
#pragma unroll
                for (int j = 0; j < 4; ++j) DT[(size_t)(rb + (F.lane >> 4) * 4 + j) * 16 + (F.lane & 15)] = t[j]; }
            __syncthreads(); }
    }
}

__device__ __forceinline__ void phase_norm2(Frame& F, const Args& A, int l) {
    bf16* U = (bf16*)(F.ws + WS_U); f32x4 wv[8]; load_normw(A.in[I_FNW] + l * DM, wv, F.lane);
    LAS float* lg = (LAS float*)F.lds;
    LAS int* s_e = (LAS int*)(F.lds + 16384); LAS float* s_w = (LAS float*)(F.lds + 16384 + 512); LAS int* s_rank = (LAS int*)(F.lds + 16384 + 1024);
    LAS int* lcnt = (LAS int*)(F.lds + 16384 + 1536); LAS int* lbase = (LAS int*)(F.lds + 16384 + 1664);
    int* tokl = (int*)(F.ws + WS_TOK); float* wtl = (float*)(F.ws + WS_WT); int* slot = (int*)(F.ws + WS_SLOT);
    for (int blk = F.bid; blk < NTOK / 64; blk += F.G) {
        const int row0 = blk * 64;
        for (int r = 0; r < 8; r += 2) { const int row = row0 + F.wave * 8 + r;
            const float* src[2] = {F.out + (size_t)row * DM, F.out + (size_t)(row + 1) * DM}; float* hd[2] = {nullptr, nullptr}; const bf16* ya[2] = {nullptr, nullptr};
            bf16* ud[2] = {U + (size_t)row * DM, U + (size_t)(row + 1) * DM}; float* fd[2] = {nullptr, nullptr};
            unsigned char* u8[2] = {F.ws + WS_U8 + (size_t)row * DM, F.ws + WS_U8 + (size_t)(row + 1) * DM};
            if (MOE_FP8) norm_rows<0, 2, true>(src, hd, ya, ya, wv, ud, fd, F.lane, u8); else norm_rows<0, 2>(src, hd, ya, ya, wv, ud, fd, F.lane); }
        if (F.tid < 32) lcnt[F.tid] = 0;
        VM_WAIT(); __syncthreads();
        { f32x4 acc[3]; const int rt = F.wave & 3, kh = F.wave >> 2, rb = rt * 16;
            mini_gemm16<3>(U + (size_t)(row0 + rb) * DM, (const bf16*)(F.ws + WS_WR + l * SZ_WR), acc, F.lane, kh * 32, kh * 32 + 32);
            LAS f32x4* part = (LAS f32x4*)(F.lds + 32768);
            if (kh == 1) {
#pragma unroll
                for (int c = 0; c < 3; ++c) part[(rt * 3 + c) * 64 + F.lane] = acc[c]; }
            __syncthreads();
            if (kh == 0) {
#pragma unroll
                for (int c = 0; c < 3; ++c) { const f32x4 t = acc[c] + part[(rt * 3 + c) * 64 + F.lane];
#pragma unroll
                    for (int j = 0; j < 4; ++j) lg[(rb + (F.lane >> 4) * 4 + j) * 48 + c * 16 + (F.lane & 15)] = t[j]; } } }
        __syncthreads();
        if (F.tid < 64) { const LAS float* L = lg + F.tid * 48;
            const float* bg = A.in[I_RGB] + l * 4; const float* be = A.in[I_REB] + l * 32;
            float gl[4]; int g = 0;
#pragma unroll
            for (int j = 0; j < 4; ++j) gl[j] = L[j] + bg[j];
#pragma unroll
            for (int j = 1; j < 4; ++j) if (gl[j] > gl[g]) g = j;
            float den = 0.f;
#pragma unroll
            for (int j = 0; j < 4; ++j) den += __expf(gl[j] - gl[g]);
            const float gate = 1.f / den;
            float el[8];
#pragma unroll
            for (int j = 0; j < 8; ++j) el[j] = L[4 + g * 8 + j] + be[g * 8 + j];
            int i1 = 0;
#pragma unroll
            for (int j = 1; j < 8; ++j) if (el[j] > el[i1]) i1 = j;
            int i2 = (i1 == 0) ? 1 : 0;
#pragma unroll
            for (int j = 0; j < 8; ++j) if (j != i1 && el[j] > el[i2]) i2 = j;
            const float w1 = gate / (1.f + __expf(el[i2] - el[i1])), w2 = gate - w1;
            s_e[2 * F.tid] = g * 8 + i1; s_e[2 * F.tid + 1] = g * 8 + i2; s_w[2 * F.tid] = w1; s_w[2 * F.tid + 1] = w2; }
        __syncthreads();
        if (F.tid < 128) s_rank[F.tid] = __hip_atomic_fetch_add(lcnt + s_e[F.tid], 1, __ATOMIC_RELAXED, __HIP_MEMORY_SCOPE_WORKGROUP);
        __syncthreads();
        if (F.tid < 32) { const int c = lcnt[F.tid]; lbase[F.tid] = c ? (int)__hip_atomic_fetch_add(F.ctl + CW_CNT + (l * NEXP + F.tid) * 64, (unsigned)c, RLX_AGENT) : 0; }
        __syncthreads();
        if (F.tid < 128) { const int e = s_e[F.tid], pos = lbase[e] + s_rank[F.tid], tok = row0 + (F.tid >> 1);
            tokl[(size_t)e * NTOK + pos] = tok; wtl[(size_t)e * NTOK + pos] = s_w[F.tid]; slot[tok * 2 + (F.tid & 1)] = (e << 16) | pos; }
        __syncthreads();
    }
}

enum { MX_RET = 0, MX_SSD = 1, MX_HGRN = 2 };
constexpr int IM_QA = 0, IM_QB = 16384, IM_KB = 32768, IM_KS = 73728, IM_V = 90112, IM_VS = 98304, IM_P = 106496, IM_ST = 114688;
constexpr int SM_CUM = TAB_OFF + T_END * 4, SM_TOT = SM_CUM + 512, SM_LAST = SM_TOT + 2048, SM_CW = SM_LAST + 512, SM_END = SM_CW + 6400;
static_assert(IM_ST + 16384 <= RING_BYTES && SM_END <= LDS_BYTES, "mixer LDS map");
typedef short s16x4 __attribute__((ext_vector_type(4)));
__device__ __forceinline__ unsigned img256(unsigned r, unsigned ch) { return 256u * r + 16u * (ch ^ (((r & 3u) << 2) | ((r >> 2) & 3u))); }
__device__ __forceinline__ unsigned imgP(unsigned r, unsigned ch) { return 128u * r + 16u * (ch ^ ((r >> 1) & 7u)); }
__device__ __forceinline__ unsigned imgV(unsigned r, unsigned ch) { return 128u * r + 16u * (ch ^ ((((r >> 1) & 1u) | (((r >> 3) & 1u) << 1)) << 1)); }
__device__ __forceinline__ bf16x8 tr_pair(LAS unsigned char* base, unsigned a0, unsigned a1) {
    const s16x4 lo = __builtin_amdgcn_ds_read_tr16_b64_v4i16((LAS s16x4*)(base + a0));
    const s16x4 hi = __builtin_amdgcn_ds_read_tr16_b64_v4i16((LAS s16x4*)(base + a1));
    return __builtin_shufflevector(lo, hi, 0, 1, 2, 3, 4, 5, 6, 7);
}
__device__ __forceinline__ void unpack8(const v4u x, float (&f)[8]) {
    f[0] = __uint_as_float(x.x << 16); f[1] = __uint_as_float(x.x & 0xffff0000u); f[2] = __uint_as_float(x.y << 16); f[3] = __uint_as_float(x.y & 0xffff0000u);
    f[4] = __uint_as_float(x.z << 16); f[5] = __uint_as_float(x.z & 0xffff0000u); f[6] = __uint_as_float(x.w << 16); f[7] = __uint_as_float(x.w & 0xffff0000u); }
__device__ __forceinline__ v4u pack8(const float (&f)[8]) { v4u w; w.x = pk2(f[0], f[1]); w.y = pk2(f[2], f[3]); w.z = pk2(f[4], f[5]); w.w = pk2(f[6], f[7]); return w; }


__device__ __forceinline__ void phase_conv(Frame& F, const Args& A, int l) {
    const bf16* P = (const bf16*)(F.ws + WS_P); bf16* XC = (bf16*)(F.ws + WS_XC);
    const float* cw = A.in[I_CONVW] + l * 4 * CONVD; const float* cb = A.in[I_CONVB] + l * CONVD;
    const int gt = F.bid * (NWAVES * 64) + F.tid, NGT = F.G * NWAVES * 64;
    for (int it = gt; it < (NTOK / 16) * 192; it += NGT) {
        const int rb = it / 192, cch = it - rb * 192, ch0 = cch * 8, row0 = rb * 16, tseq = row0 & (SEQ - 1);
        float cwr[4][8], cbr[8];
#pragma unroll
        for (int j = 0; j < 4; ++j) { const f32x4 a0 = *(const f32x4*)(cw + j * CONVD + ch0), a1 = *(const f32x4*)(cw + j * CONVD + ch0 + 4);
#pragma unroll
            for (int e = 0; e < 4; ++e) { cwr[j][e] = a0[e]; cwr[j][4 + e] = a1[e]; } }
        { const f32x4 b0 = *(const f32x4*)(cb + ch0), b1 = *(const f32x4*)(cb + ch0 + 4);
#pragma unroll
            for (int e = 0; e < 4; ++e) { cbr[e] = b0[e]; cbr[4 + e] = b1[e]; } }
        v4u xr[19];
#pragma unroll
        for (int rr = 0; rr < 19; ++rr) xr[rr] = (tseq + rr - 3 >= 0) ? *(const v4u*)(P + PB((size_t)(row0 + rr - 3), C_SX + ch0)) : (v4u){0u, 0u, 0u, 0u};
        float xs[4][8];
        unpack8(xr[0], xs[0]); unpack8(xr[1], xs[1]); unpack8(xr[2], xs[2]);
#pragma unroll
        for (int e = 0; e < 16; ++e) { float acc[8];
            unpack8(xr[e + 3], xs[(e + 3) & 3]);
#pragma unroll
            for (int c = 0; c < 8; ++c) acc[c] = cbr[c];
#pragma unroll
            for (int j = 0; j < 4; ++j)
#pragma unroll
                for (int c = 0; c < 8; ++c) acc[c] = fmaf(cwr[j][c], xs[(e + j) & 3][c], acc[c]);
#pragma unroll
            for (int c = 0; c < 8; ++c) acc[c] = siluf(acc[c]);
            *(v4u*)(XC + (size_t)(row0 + e) * CONVD + ch0) = pack8(acc); }
    }
}
#define IM_HCOPY(p) ((p) < 1024 ? IM_QB + (p) * 16 : ((p) < 2048 ? IM_KS + ((p) - 1024) * 16 : IM_P + ((p) - 2048) * 16))
#define MIX_BAR() do { asm volatile("s_waitcnt lgkmcnt(0)" ::: "memory"); __builtin_amdgcn_s_barrier(); asm volatile("" ::: "memory"); } while (0)

__device__ __forceinline__ void hgrn_prep_unit(Frame& F, const Args& A, int l, int b, int h, int n) {
    LAS unsigned char* lds = F.lds;
    const bf16* P = (const bf16*)(F.ws + WS_P);
    LAS float* totv = (LAS float*)(lds + SM_TOT); LAS float* lastv = (LAS float*)(lds + SM_LAST);
    const int tid = F.tid, w = F.wave;
    int lz = F.lane; asm volatile("" : "+v"(lz));
    const int fr = lz & 15, g = lz >> 4;
    const int ia = w >> 1, cc0 = (w & 1) * 2;
    const size_t row0 = (size_t)b * SEQ + n * 64;
    const int kk = tid & 127, sa = w >> 1;
    float hlb = 0.f;
    if (l > 0) { const float x0 = A.in[I_HLB][h * 128 + kk], x1 = A.in[I_HLB][512 + h * 128 + kk]; hlb = __builtin_amdgcn_rcpf(1.f + __expf(x0 - x1)); }
    const float hlbf = fmaxf(hlb, 1e-30f);
    bf16 hq[16], hf[16];
#pragma unroll
    for (int r = 0; r < 16; ++r) { const size_t pr_ = row0 + 16 * sa + r; hq[r] = P[PB(pr_, C_HQ + h * 128 + kk)]; hf[r] = P[PB(pr_, C_HF + h * 128 + kk)]; }
    float qv[16], kv[16], plr[16]; float pl = 1.f;
#pragma unroll
    for (int r = 0; r < 16; ++r) {
        const float qx = bf2f(hq[r]), fx = bf2f(hf[r]);
        const float sg = sigmf(fx);
        qv[r] = siluf(qx) * 0.08838834764831845f; kv[r] = (1.f - hlb) * (1.f - sg); pl *= hlbf + (1.f - hlb) * sg; plr[r] = pl; }
    totv[sa * 128 + kk] = pl;
    MIX_BAR();
    const float tt0 = totv[kk], tt1 = totv[128 + kk], tt2 = totv[256 + kk], tt3 = totv[384 + kk];
    if (sa == 0) lastv[kk] = tt0 * tt1 * tt2 * tt3;
    const float Ra = sa == 0 ? 1.f : (sa == 1 ? tt0 : (sa == 2 ? tt0 * tt1 : tt0 * tt1 * tt2));
    const float Ua = sa == 0 ? tt0 * tt1 * tt2 * tt3 : (sa == 1 ? tt1 * tt2 * tt3 : (sa == 2 ? tt2 * tt3 : tt3));
    const unsigned cb2 = (unsigned)(kk & 7) * 2u, chk = (unsigned)kk >> 3;
#pragma unroll
    for (int r = 0; r < 16; ++r) { const unsigned t = 16 * sa + r; const float qa = qv[r] * plr[r], ik = kv[r] * __builtin_amdgcn_rcpf(fmaxf(plr[r], 1e-30f));
        *(LAS bf16*)(lds + IM_QA + img256(t, chk) + cb2) = f2bf1(qa);
        *(LAS bf16*)(lds + IM_QB + img256(t, chk) + cb2) = f2bf1(qa * Ra);
        *(LAS bf16*)(lds + IM_KS + img256(t, chk) + cb2) = f2bf1(ik * Ua);
        float m = 1.f;
#pragma unroll
        for (int ap = 0; ap < 4; ++ap) if (ap >= sa) {
            if (ap > sa) m *= (ap == 1 ? tt0 : (ap == 2 ? tt1 : tt2));
            *(LAS bf16*)(lds + IM_KB + img256(16 * (ap * (ap + 1) / 2 + sa) + r, chk) + cb2) = f2bf1(ik * m); }
    }
    MIX_BAR();
    bf16x8 qa4[4];
#pragma unroll
    for (int ks = 0; ks < 4; ++ks) qa4[ks] = *(const LAS bf16x8*)(lds + IM_QA + img256(16 * ia + fr, 4 * ks + g));
#pragma unroll
    for (int jj = 0; jj < 2; ++jj) { const int jb = cc0 + jj; v2u pw = (v2u){0u, 0u};
        if (jb <= ia) {
            f32x4 sc = (f32x4){0.f, 0.f, 0.f, 0.f};
            const unsigned kbrow = 16u * (ia * (ia + 1) / 2 + jb);
#pragma unroll
            for (int ks = 0; ks < 4; ++ks) { const bf16x8 kf = *(const LAS bf16x8*)(lds + IM_KB + img256(kbrow + fr, 4 * ks + g)); sc = __builtin_amdgcn_mfma_f32_16x16x32_bf16(kf, qa4[ks], sc, 0, 0, 0); }
            if (jb == ia) {
#pragma unroll
                for (int r = 0; r < 4; ++r) sc[r] = (4 * g + r <= fr) ? sc[r] : 0.f; }
            pw.x = pk2(sc[0], sc[1]); pw.y = pk2(sc[2], sc[3]);
        }
        *(LAS v2u*)(lds + IM_P + imgP(16 * ia + fr, 2 * jb + (g >> 1)) + 8 * (g & 1)) = pw;
    }
    MIX_BAR();
    unsigned char* rec = F.ws + WS_HP + ((size_t)(b * 4 + h) * 32 + n) * HPU;
#pragma unroll
    for (int j = 0; j < 5; ++j) { const int p = tid + 512 * j; *(v4u*)(rec + (size_t)p * 16) = *(const LAS v4u*)(lds + IM_HCOPY(p)); }
    if (tid < 32) *(f32x4*)(rec + 40960 + tid * 16) = *(const LAS f32x4*)(lastv + 4 * tid);
    MIX_BAR();
}

__device__ __forceinline__ void phase_ssd_dt(Frame& F, const Args& A, int l) {
    const float* DT = (const float*)(F.ws + WS_DT); f32x4* SD = (f32x4*)(F.ws + WS_SD);
    const int gw = F.bid * NWAVES + F.wave, NGW = F.G * NWAVES, lane = F.lane;
    for (int it = gw; it < 8 * 16 * (SEQ / 64); it += NGW) { const int n = it & 31, h = (it >> 5) & 15, b = it >> 9;
        const float dtb = A.in[I_DTB][l * 16 + h], Aneg = -__expf(A.in[I_ALOG][l * 16 + h]);
        const float xdt = DT[((size_t)b * SEQ + n * 64 + lane) * 16 + h] + dtb;
        const float dt = xdt > 20.f ? xdt : log1pf(__expf(xdt));
        float cum = dt * Aneg;
#pragma unroll
        for (int o = 1; o < 64; o <<= 1) { const float tmp = __shfl_up(cum, o); if (lane >= o) cum += tmp; }
        const float wl = __expf(__shfl(cum, 63) - cum);
        SD[((size_t)(b * 16 + h)) * SEQ + n * 64 + lane] = (f32x4){dt, cum, wl, __expf(cum)}; }
}
template <int TYPE>
__device__ __forceinline__ void mix_stream(Frame& F, const Args& A, int l, int b, int h, int half) {
    LAS unsigned char* lds = F.lds;
    const bf16* P = (const bf16*)(F.ws + WS_P); bf16* MO = (bf16*)(F.ws + WS_U);
    LAS float* cumv = (LAS float*)(lds + SM_CUM); LAS float* totv = (LAS float*)(lds + SM_TOT); LAS float* lastv = (LAS float*)(lds + SM_LAST);
    const int tid = F.tid, w = F.wave, lane = F.lane;
    const int ia = w >> 1, cc0 = (w & 1) * 2;
    const int ocol = TYPE == MX_RET ? h * 128 + half * 64 : (TYPE == MX_SSD ? 512 + h * 64 : 1536 + h * 128 + half * 64);
    f32x4 S[4];
#pragma unroll
    for (int c = 0; c < 4; ++c) S[c] = (f32x4){0.f, 0.f, 0.f, 0.f};
    for (int i = tid; i < 1024; i += NWAVES * 64) ((LAS v4u*)(lds + IM_ST))[i] = (v4u){0u, 0u, 0u, 0u};
    const int pt = tid >> 3, pib = tid & 7;
    float vs_scale = 1.f;
    float dtb = 0.f, Aneg = 0.f, dsk = 0.f;
    if constexpr (TYPE == MX_RET) {
        const float lg2 = log2f(1.f - exp2f(-5.f - (float)h));
        vs_scale = exp2f((float)(63 - pt) * lg2);
        if (tid < 64) cumv[tid] = (float)(tid + 1) * lg2 * 0.6931471805599453f;
    }
    if constexpr (TYPE == MX_SSD) {
        dtb = A.in[I_DTB][l * 16 + h]; Aneg = -__expf(A.in[I_ALOG][l * 16 + h]); dsk = A.in[I_SSDD][l * 16 + h];
    }
    const float* cosT = (const float*)(F.ws + WS_ROT); const float* sinT = (const float*)(F.ws + WS_ROT + SZ_ROT);
    v4u rq0, rq1, rk0, rk1, rv; f32x4 rc0, rc1, rs0, rs1;
    f32x4 rsd = (f32x4){0.f, 0.f, 0.f, 0.f};
    v4u hp[5]; f32x4 hlv = (f32x4){0.f, 0.f, 0.f, 0.f};
#define MIX_LOAD(nn) do { const int t0n = (nn) * 64; const size_t row0n = (size_t)b * SEQ + t0n; \
        if constexpr (TYPE == MX_RET) { const size_t pr_ = row0n + pt; \
            rq0 = *(const v4u*)(P + PB(pr_, C_RQ + h * 128 + 8 * pib)); rq1 = *(const v4u*)(P + PB(pr_, C_RQ + h * 128 + 64 + 8 * pib)); \
            rk0 = *(const v4u*)(P + PB(pr_, C_RK + h * 128 + 8 * pib)); rk1 = *(const v4u*)(P + PB(pr_, C_RK + h * 128 + 64 + 8 * pib)); \
            rv = *(const v4u*)(P + PB(pr_, C_RV + h * 128 + half * 64 + 8 * pib)); \
            const f32x4* cp = (const f32x4*)(cosT + (size_t)(t0n + pt) * 64 + 8 * pib); const f32x4* sp = (const f32x4*)(sinT + (size_t)(t0n + pt) * 64 + 8 * pib); \
            rc0 = cp[0]; rc1 = cp[1]; rs0 = sp[0]; rs1 = sp[1]; } \
        if constexpr (TYPE == MX_SSD) { rsd = ((const f32x4*)(F.ws + WS_SD))[(size_t)(b * 16 + h) * SEQ + t0n + lane]; \
            const bf16* xc = (const bf16*)(F.ws + WS_XC) + (row0n + pt) * CONVD; const int grp_ = h >> 3; \
            rq0 = *(const v4u*)(xc + 1280 + grp_ * 128 + 8 * pib); rq1 = *(const v4u*)(xc + 1280 + grp_ * 128 + 64 + 8 * pib); \
            rk0 = *(const v4u*)(xc + 1024 + grp_ * 128 + 8 * pib); rk1 = *(const v4u*)(xc + 1024 + grp_ * 128 + 64 + 8 * pib); \
            rv = *(const v4u*)(xc + h * 64 + 8 * pib); } \
        if constexpr (TYPE == MX_HGRN) { const unsigned char* rec = F.ws + WS_HP + ((size_t)(b * 4 + h) * 32 + (nn)) * HPU; \
            _Pragma("unroll") for (int j = 0; j < 5; ++j) hp[j] = *(const v4u*)(rec + (size_t)(tid + 512 * j) * 16); \
            if (tid < 32) hlv = *(const f32x4*)(rec + 40960 + tid * 16); \
            rv = *(const v4u*)(P + PB(row0n + pt, C_HI + h * 128 + half * 64 + 8 * pib)); } \
    } while (0)
    MIX_LOAD(0);
    MIX_BAR();

    for (int n = 0; n < SEQ / 64; ++n) {
        const int t0 = n * 64; const size_t row0 = (size_t)b * SEQ + t0;
        int lz = lane; asm volatile("" : "+v"(lz));
        const int fr = lz & 15, g = lz >> 4, q4 = fr >> 2, p4 = fr & 3;
        bf16 zr[2][4];
        if constexpr (TYPE == MX_SSD) {
#pragma unroll
            for (int cc = 0; cc < 2; ++cc)
#pragma unroll
                for (int r = 0; r < 4; ++r) zr[cc][r] = P[PB(row0 + 16 * ia + 4 * g + r, C_SZ + h * 64 + 16 * (cc0 + cc) + fr)];
        }
        if constexpr (TYPE == MX_RET) {
            float ql[8], qh[8], kl[8], kh[8], vv[8], cs[8], sn[8], o0[8], o1[8];
            unpack8(rq0, ql); unpack8(rq1, qh); unpack8(rk0, kl); unpack8(rk1, kh); unpack8(rv, vv);
#pragma unroll
            for (int e = 0; e < 4; ++e) { cs[e] = rc0[e]; cs[4 + e] = rc1[e]; sn[e] = rs0[e]; sn[4 + e] = rs1[e]; }
#pragma unroll
            for (int e = 0; e < 8; ++e) { o0[e] = ql[e] * cs[e] - qh[e] * sn[e]; o1[e] = ql[e] * sn[e] + qh[e] * cs[e]; }
            *(LAS v4u*)(lds + IM_QA + img256(pt, pib)) = pack8(o0); *(LAS v4u*)(lds + IM_QA + img256(pt, 8 + pib)) = pack8(o1);
#pragma unroll
            for (int e = 0; e < 8; ++e) { o0[e] = (kl[e] * cs[e] - kh[e] * sn[e]) * 0.08838834764831845f; o1[e] = (kl[e] * sn[e] + kh[e] * cs[e]) * 0.08838834764831845f; }
            *(LAS v4u*)(lds + IM_KB + img256(pt, pib)) = pack8(o0); *(LAS v4u*)(lds + IM_KB + img256(pt, 8 + pib)) = pack8(o1);
            *(LAS v4u*)(lds + IM_V + imgV(pt, pib)) = pack8(vv);
#pragma unroll
            for (int e = 0; e < 8; ++e) vv[e] *= vs_scale;
            *(LAS v4u*)(lds + IM_VS + imgV(pt, pib)) = pack8(vv);
        }
        if constexpr (TYPE == MX_SSD) {
            if (w == 0) { cumv[lane] = rsd[1]; cumv[64 + lane] = rsd[3]; }
            const float sdt = __shfl(rsd[0], pt), swl = __shfl(rsd[2], pt);
            float kl[8], kh[8], vv[8];
            unpack8(rk0, kl); unpack8(rk1, kh); unpack8(rv, vv);
            *(LAS v4u*)(lds + IM_QA + img256(pt, pib)) = rq0; *(LAS v4u*)(lds + IM_QA + img256(pt, 8 + pib)) = rq1;
#pragma unroll
            for (int e = 0; e < 8; ++e) { kl[e] *= sdt; kh[e] *= sdt; }
            *(LAS v4u*)(lds + IM_KB + img256(pt, pib)) = pack8(kl); *(LAS v4u*)(lds + IM_KB + img256(pt, 8 + pib)) = pack8(kh);
            *(LAS v4u*)(lds + IM_V + imgV(pt, pib)) = rv;
#pragma unroll
            for (int e = 0; e < 8; ++e) vv[e] *= swl;
            *(LAS v4u*)(lds + IM_VS + imgV(pt, pib)) = pack8(vv);
        }
        if constexpr (TYPE == MX_HGRN) {
#pragma unroll
            for (int j = 0; j < 5; ++j) *(LAS v4u*)(lds + IM_HCOPY(tid + 512 * j)) = hp[j];
            *(LAS v4u*)(lds + IM_V + imgV(pt, pib)) = rv;
            if (tid < 32) *(LAS f32x4*)(lastv + 4 * tid) = hlv;
        }
        { const int nn = n + 1 < SEQ / 64 ? n + 1 : n; MIX_LOAD(nn); }
        MIX_BAR();
        bf16x8 qa[4];
#pragma unroll
        for (int ks = 0; ks < 4; ++ks) qa[ks] = *(const LAS bf16x8*)(lds + IM_QA + img256(16 * ia + fr, 4 * ks + g));
#pragma unroll
        for (int jj = 0; jj < 2; ++jj) if (TYPE != MX_HGRN) { const int jb = cc0 + jj; v2u pw = (v2u){0u, 0u};
            if (jb <= ia) {
                f32x4 sc = (f32x4){0.f, 0.f, 0.f, 0.f};
                const unsigned kbrow = TYPE == MX_HGRN ? 16u * (ia * (ia + 1) / 2 + jb) : 16u * jb;
#pragma unroll
                for (int ks = 0; ks < 4; ++ks) { const bf16x8 kf = *(const LAS bf16x8*)(lds + IM_KB + img256(kbrow + fr, 4 * ks + g)); sc = __builtin_amdgcn_mfma_f32_16x16x32_bf16(kf, qa[ks], sc, 0, 0, 0); }
                if constexpr (TYPE != MX_HGRN) { const float ci = cumv[16 * ia + fr]; const f32x4 cj = *(const LAS f32x4*)(cumv + 16 * jb + 4 * g);
#pragma unroll
                    for (int r = 0; r < 4; ++r) sc[r] *= __expf(fminf(ci - cj[r], 0.f)); }
                if (jb == ia) {
#pragma unroll
                    for (int r = 0; r < 4; ++r) sc[r] = (4 * g + r <= fr) ? sc[r] : 0.f; }
                pw.x = pk2(sc[0], sc[1]); pw.y = pk2(sc[2], sc[3]);
            }
            *(LAS v2u*)(lds + IM_P + imgP(16 * ia + fr, 2 * jb + (g >> 1)) + 8 * (g & 1)) = pw;
        }
        f32x4 qs[2];
        {
            bf16x8 qb[4];
            if constexpr (TYPE == MX_HGRN) {
#pragma unroll
                for (int ks = 0; ks < 4; ++ks) qb[ks] = *(const LAS bf16x8*)(lds + IM_QB + img256(16 * ia + fr, 4 * ks + g));
            } else {
#pragma unroll
                for (int ks = 0; ks < 4; ++ks) qb[ks] = qa[ks];
            }
#pragma unroll
            for (int cc = 0; cc < 2; ++cc) { qs[cc] = (f32x4){0.f, 0.f, 0.f, 0.f};
#pragma unroll
                for (int ks = 0; ks < 4; ++ks) { const bf16x8 sf = *(const LAS bf16x8*)(lds + IM_ST + img256(16 * (cc0 + cc) + fr, 4 * ks + g)); qs[cc] = __builtin_amdgcn_mfma_f32_16x16x32_bf16(qb[ks], sf, qs[cc], 0, 0, 0); } }
        }
        MIX_BAR();
        {
            const unsigned tra0 = (unsigned)(8 * g + q4), trc = (unsigned)(p4 >> 1), trb = 8u * (unsigned)(p4 & 1);
#pragma unroll
            for (int cc = 0; cc < 2; ++cc) { const int c = cc0 + cc; f32x4 pv = (f32x4){0.f, 0.f, 0.f, 0.f};
#pragma unroll
                for (int ks = 0; ks < 2; ++ks) if (ks == 0 || ia >= 2) {
                    const bf16x8 pf = *(const LAS bf16x8*)(lds + IM_P + imgP(16 * ia + fr, 4 * ks + g));
                    const bf16x8 vf = tr_pair(lds + IM_V, imgV(32 * ks + tra0, 2 * c + trc) + trb, imgV(32 * ks + tra0 + 4, 2 * c + trc) + trb);
                    pv = __builtin_amdgcn_mfma_f32_16x16x32_bf16(pf, vf, pv, 0, 0, 0); }
#pragma unroll
                for (int r = 0; r < 4; ++r) { const int i = 16 * ia + 4 * g + r, v = 16 * c + fr; float o;
                    if constexpr (TYPE == MX_HGRN) o = pv[r] + qs[cc][r]; else if constexpr (TYPE == MX_SSD) o = pv[r] + cumv[64 + i] * qs[cc][r]; else o = pv[r] + __expf(cumv[i]) * qs[cc][r];
                    if constexpr (TYPE == MX_SSD) { const float xv = bf2f(*(const LAS bf16*)(lds + IM_V + imgV(i, v >> 3) + (v & 7) * 2)); o = (o + dsk * xv) * siluf(bf2f(zr[cc][r])); }
                    MO[(row0 + i) * DM + ocol + v] = f2bf1(o); }
            }
            if constexpr (TYPE == MX_HGRN) { const f32x4 d = *(const LAS f32x4*)(lastv + 16 * w + 4 * g);
#pragma unroll
                for (int c = 0; c < 4; ++c) S[c] = S[c] * d; }
            else { const float d = TYPE == MX_SSD ? cumv[64 + 63] : __expf(cumv[63]);
#pragma unroll
                for (int c = 0; c < 4; ++c) S[c] = S[c] * d; }
            constexpr int IMK = TYPE == MX_HGRN ? IM_KS : IM_KB, IMV2 = TYPE == MX_HGRN ? IM_V : IM_VS;
#pragma unroll
            for (int ks = 0; ks < 2; ++ks) {
                const bf16x8 af = tr_pair(lds + IMK, img256(32 * ks + tra0, 2 * w + trc) + trb, img256(32 * ks + tra0 + 4, 2 * w + trc) + trb);
#pragma unroll
                for (int c = 0; c < 4; ++c) { const bf16x8 bv = tr_pair(lds + IMV2, imgV(32 * ks + tra0, 2 * c + trc) + trb, imgV(32 * ks + tra0 + 4, 2 * c + trc) + trb);
                    S[c] = __builtin_amdgcn_mfma_f32_16x16x32_bf16(af, bv, S[c], 0, 0, 0); } }
        }
        MIX_BAR();
#pragma unroll
        for (int c = 0; c < 4; ++c) { v2u sw; sw.x = pk2(S[c][0], S[c][1]); sw.y = pk2(S[c][2], S[c][3]);
            *(LAS v2u*)(lds + IM_ST + img256(16 * c + fr, 2 * w + (g >> 1)) + 8 * (g & 1)) = sw; }
    }
    VM_WAIT(); MIX_BAR();
#undef MIX_LOAD
}

__device__ __forceinline__ void phase_mix(Frame& F, const Args& A, int l) {
    { const int s = F.bid;
        if (s < 64) { { const int x = s & 7, j = s >> 3, pr = (j >> 1) * 8 + x; mix_stream<MX_RET>(F, A, l, pr >> 2, pr & 3, j & 1); }     }
        else if (s < 192) { const int sb = s - 64; { const int x = sb & 7, j = sb >> 3, pg = (j >> 3) * 8 + x; mix_stream<MX_SSD>(F, A, l, pg >> 1, (pg & 1) * 8 + (j & 7), 0); }     }
        else { const int sb = s - 192; { const int x = sb & 7, j = sb >> 3, pr = (j >> 1) * 8 + x; mix_stream<MX_HGRN>(F, A, l, pr >> 2, pr & 3, j & 1); } }
    }
}

__device__ __forceinline__ void phase_ssdnorm(Frame& F, const Args& A, int l) {
    bf16* MO = (bf16*)(F.ws + WS_U); const bf16* P = (const bf16*)(F.ws + WS_P);
    const int gw = F.bid * NWAVES + F.wave, NGW = F.G * NWAVES, lane = F.lane;
    const int kind = lane < 16 ? 0 : (lane < 48 ? 1 : 2);
    float wq[32];
    { const float* wp = kind == 1 ? A.in[I_SSDNW] + l * 1024 + 32 * (lane - 16) : A.in[I_HNW] + l * 512 + 32 * ((lane - 48) & 15);
#pragma unroll
        for (int j = 0; j < 32; ++j) wq[j] = kind != 0 ? wp[j] : 1.f; }
    for (int row = gw; row < NTOK; row += 2 * NGW) {
        v4u xin[2][4], gin[2][4];
#pragma unroll
        for (int q = 0; q < 2; ++q) { const size_t rw = (size_t)row + (size_t)q * NGW;
            const v4u* p = (const v4u*)(MO + rw * DM + 32 * lane);
            const v4u* gp = (const v4u*)(P + PB(rw, kind == 0 ? C_RG + 32 * lane : C_HG + 32 * ((lane - 48) & 15)));
#pragma unroll
            for (int c = 0; c < 4; ++c) { xin[q][c] = p[c]; gin[q][c] = kind != 1 ? gp[c] : (v4u){0u, 0u, 0u, 0u}; } }
#pragma unroll
        for (int q = 0; q < 2; ++q) { const size_t rw = (size_t)row + (size_t)q * NGW;
            float f[32];
#pragma unroll
            for (int c = 0; c < 4; ++c) { float t8[8]; unpack8(xin[q][c], t8);
#pragma unroll
                for (int j = 0; j < 8; ++j) f[8 * c + j] = t8[j]; }
            float ss = 0.f;
#pragma unroll
            for (int j = 0; j < 32; ++j) ss += f[j] * f[j];
            ss += __shfl_xor(ss, 1); ss += __shfl_xor(ss, 2);
            float s16 = ss; s16 += __shfl_xor(s16, 4); s16 += __shfl_xor(s16, 8);
            const float rstd = 1.f / sqrtf((kind == 1 ? s16 * (1.f / 512.f) : ss * (1.f / 128.f)) + EPS);
            v4u* po = (v4u*)(MO + rw * DM + 32 * lane);
#pragma unroll
            for (int c = 0; c < 4; ++c) { float o[8], gg[8]; unpack8(gin[q][c], gg);
#pragma unroll
                for (int j = 0; j < 8; ++j) { float v = f[8 * c + j] * rstd * wq[8 * c + j]; if (kind != 1) v *= siluf(gg[j]); o[j] = v; }
                po[c] = pack8(o); }
        }
    }
}

__device__ __forceinline__ void phase_final(Frame& F, const Args& A) {
    const bf16* Y = (const bf16*)(F.ws + WS_Y); const int* slot = (const int*)(F.ws + WS_SLOT);
    build_tables(F, NLAYER - 1);
    const int gw = F.bid * NWAVES + F.wave, NGW = F.G * NWAVES;
    f32x4 wv[8]; load_normw(A.in[I_FINW], wv, F.lane);
    for (int row = gw; row < NTOK; row += 2 * NGW) {
        const float* src[2]; float* hd[2] = {nullptr, nullptr}; const bf16* ya[2]; const bf16* yb[2]; bf16* ud[2] = {nullptr, nullptr}; float* fd[2];
#pragma unroll
        for (int q = 0; q < 2; ++q) { const int rw = row + q * NGW; const int s0 = slot[rw * 2], s1 = slot[rw * 2 + 1];
            ya[q] = Y + ((size_t)F.tab[T_EBASE + (s0 >> 16)] * 256 + (s0 & 0xffff)) * (MOE_FP8 ? DM / 2 : DM); yb[q] = Y + ((size_t)F.tab[T_EBASE + (s1 >> 16)] * 256 + (s1 & 0xffff)) * (MOE_FP8 ? DM / 2 : DM);
            src[q] = F.out + (size_t)rw * DM; fd[q] = F.out + (size_t)rw * DM; }
        norm_rows<2, 2>(src, hd, ya, yb, wv, ud, fd, F.lane); }
}

constexpr int NPH = 8, GP_TOTAL = 2 + NLAYER * NPH;
__global__ void __launch_bounds__(NWAVES * 64, 2) mk_fwd(Args args) {
    extern __shared__ __attribute__((aligned(16))) unsigned char lds[];
    Frame F;
    F.lds = (LAS unsigned char*)lds;
    F.MISC = (volatile LAS unsigned*)(F.lds + MISC_OFF);
    F.tab = (LAS int*)(F.lds + TAB_OFF);
    F.tid = threadIdx.x; F.lane = F.tid & 63; F.wave = __builtin_amdgcn_readfirstlane(F.tid >> 6);
    F.G = gridDim.x; F.bid = blockIdx.x;
    F.out = args.out; F.ws = args.ws; F.ctl = (unsigned*)(args.ws + WS_CTL);
    for (int u = F.tid; u < (LDS_BYTES - LDSCTL_OFF) / 4; u += NWAVES * 64) ((LAS unsigned*)(F.lds + LDSCTL_OFF))[u] = 0u;
    __syncthreads();
    const int lo = args.gp_lo, hi = args.gp_hi;
    XcdBarrier bar; bar.bar = F.ctl + CW_BAR; bar.x = 0; bar.st = nullptr;
    if (hi - lo > 1) bar = xcd_barrier_post(F.ctl + CW_BAR, F.MISC + 8);
#define IN(k) (lo <= (k) && (k) < hi)
#define SEAM(k) do { if ((k) + 1 < hi) xcd_barrier(bar); } while (0)

    if (IN(0)) { phase_prologue(F, args); SEAM(0); }
#define LAYER_BODY(l, pb) \
        if (IN(pb + 0)) { phase_norm1(F, args, l); SEAM(pb + 0); } \
        if (IN(pb + 1)) { \
            pg8::Gemm g{(const bf16*)(F.ws + WS_U), (const bf16*)(F.ws + WS_WIN + l * SZ_WIN), NTOK, NP, DM, 0u}; pg8::StaticOrder S; \
            pg8::EpiBf16Blk E{(bf16*)(F.ws + WS_P), NTOK}; \
            if (l == 0) { if (F.bid < G1_WGS) { S.init(NTOK, NP, G1_WGS, F.bid); pg8::gemm_phase<pg8::EpiBf16Blk, pg8::StaticOrder, true>(F.lds, g, S, E); } \
                          else convert_items(F, args, CONV_SPLIT, CT_LO, (F.bid - G1_WGS) * NWAVES + F.wave, (F.G - G1_WGS) * NWAVES); } \
            else { S.init(NTOK, NP, F.G, F.bid); pg8::gemm_phase<pg8::EpiBf16Blk, pg8::StaticOrder, true>(F.lds, g, S, E); \
                   if (F.bid >= 128) convert_items(F, args, CT_LO, NLAYER * TI_LAYER, (F.bid - 128) * NWAVES + F.wave, 128 * NWAVES); } \
            SEAM(pb + 1); \
        } \
        if (IN(pb + 2)) { phase_ssd_dt(F, args, l); phase_conv(F, args, l); for (int u = F.bid; u < 1024; u += F.G) hgrn_prep_unit(F, args, l, u >> 7, (u >> 5) & 3, u & 31); xcd_barrier(bar); phase_mix(F, args, l); SEAM(pb + 2); } \
        if (IN(pb + 3)) { phase_ssdnorm(F, args, l); SEAM(pb + 3); } \
        if (IN(pb + 4)) { \
            pg8::Gemm g{(const bf16*)(F.ws + WS_U), (const bf16*)(F.ws + WS_WOUT + l * SZ_WOUT), NTOK, DM, DM, 0u}; pg8::StaticOrder S; S.init(NTOK, DM, F.G, F.bid); \
            pg8::EpiResF32 E{l == 0 ? args.in[I_X] : F.out, F.out, DM}; \
            pg8::gemm_phase<pg8::EpiResF32, pg8::StaticOrder, false>(F.lds, g, S, E); \
            SEAM(pb + 4); \
        } \
        if (IN(pb + 5)) { phase_norm2(F, args, l); SEAM(pb + 5); } \
        if (IN(pb + 6)) { \
            build_tables(F, l); \
            const int ntiles = (int)F.MISC[16]; \
            const int* tokl = (const int*)(F.ws + WS_TOK); \
            for (int i = 0; i < 4; ++i) { const int L = i * F.G + F.bid; if (L < ntiles * 4) { const int v = F.tab[T_TMAP + L / 4], e = v >> 8, lt = v & 255, cnt = F.tab[T_ECNT + e]; \
                for (int r = F.tid; r < 256; r += NWAVES * 64) { const int lr = lt * 256 + r; F.tab[T_GTAB + i * 256 + r] = tokl[(size_t)e * NTOK + (lr < cnt ? lr : 0)]; } } } \
            __syncthreads(); \
            pg8::MoeOrder<true> S{F.tab + T_TMAP, F.tab + T_GTAB, ntiles, 4, F.G, F.bid, SZ_WGU1}; \
            if (MOE_FP8) { pg8::Gemm g{(const bf16*)(F.ws + WS_U8), (const bf16*)(F.ws + WS_WGU + (size_t)l * NEXP * SZ_WGU1), PADROWS, 1024, DM / 2, 0x79797979u}; \
                pg8::EpiSwiGlu8 E{F.ws + WS_HID}; pg8::gemm_phase<pg8::EpiSwiGlu8, pg8::MoeOrder<true>, true, true>(F.lds, g, S, E); } \
            else { pg8::Gemm g{(const bf16*)(F.ws + WS_U), (const bf16*)(F.ws + WS_WGU + (size_t)l * NEXP * SZ_WGU1), PADROWS, 1024, DM, 0u}; \
                pg8::EpiSwiGlu E{(bf16*)(F.ws + WS_HID)}; pg8::gemm_phase<pg8::EpiSwiGlu, pg8::MoeOrder<true>, true>(F.lds, g, S, E); } \
            SEAM(pb + 6); \
        } \
        if (IN(pb + 7)) { \
            build_tables(F, l); \
            const int ntiles = (int)F.MISC[16]; \
            pg8::MoeOrder<false> S{F.tab + T_TMAP, F.tab + T_GTAB, ntiles, 8, F.G, F.bid, SZ_WD1}; \
            pg8::EpiScaleBf16 E{(bf16*)(F.ws + WS_Y), DM, (const float*)(F.ws + WS_WT), F.tab + T_ECNT}; \
            if (MOE_FP8) { pg8::Gemm g{(const bf16*)(F.ws + WS_HID), (const bf16*)(F.ws + WS_WD + (size_t)l * NEXP * SZ_WD1), PADROWS, DM, DEXP / 2, 0x7a7a7a7au}; \
                pg8::EpiScaleF8 E8{F.ws + WS_Y, DM, (const float*)(F.ws + WS_WT), F.tab + T_ECNT}; \
                pg8::gemm_phase<pg8::EpiScaleF8, pg8::MoeOrder<false>, true, true>(F.lds, g, S, E8); } \
            else { pg8::Gemm g{(const bf16*)(F.ws + WS_HID), (const bf16*)(F.ws + WS_WD + (size_t)l * NEXP * SZ_WD1), PADROWS, DM, DEXP, 0u}; \
                pg8::gemm_phase<pg8::EpiScaleBf16, pg8::MoeOrder<false>, true>(F.lds, g, S, E); } \
            SEAM(pb + 7); \
        }
    { constexpr int l = 0, pb = 1; LAYER_BODY(l, pb) }
    { constexpr int l = 1, pb = 1 + NPH; LAYER_BODY(l, pb) }
#undef LAYER_BODY
    if (IN(GP_TOTAL - 1)) phase_final(F, args);
#undef IN
#undef SEAM
}

extern "C" void kernel_launch(void* const* d_in, const int* in_sizes, int n_in, void* d_out, int out_size, void* d_ws, size_t ws_size, hipStream_t stream) {
    static int grid = 0;
    if (grid == 0) {
        if (n_in != 21 || out_size != NTOK * DM || ws_size < WS_END) { fprintf(stderr, "kernel_launch: unexpected shapes (n_in %d, out %d, ws %zu, need %zu)\n", n_in, out_size, ws_size, (size_t)WS_END); grid = -1; return; }
        int dev = 0, cus = 0, per_cu = 0;
        if (hipGetDevice(&dev) != hipSuccess || hipDeviceGetAttribute(&cus, hipDeviceAttributeMultiprocessorCount, dev) != hipSuccess) { grid = -1; return; }
        if (hipFuncSetAttribute((const void*)mk_fwd, hipFuncAttributeMaxDynamicSharedMemorySize, LDS_BYTES) != hipSuccess) { fprintf(stderr, "kernel_launch: hipFuncSetAttribute failed\n"); grid = -1; return; }
        if (hipOccupancyMaxActiveBlocksPerMultiprocessor(&per_cu, (const void*)mk_fwd, NWAVES * 64, LDS_BYTES) != hipSuccess || per_cu < 1) fprintf(stderr, "kernel_launch: occupancy query reports %d\n", per_cu);
        (void)hipGetLastError();
        grid = cus;
        if (grid != 256) { fprintf(stderr, "kernel_launch: built for a 256-CU device (got %d)\n", cus); grid = -1; return; }
    }
    if (grid < 0) return;
    if (hipMemsetAsync((char*)d_ws + WS_CTL, 0, CTL_ZERO_BYTES, stream) != hipSuccess) return;
    Args a{};
    for (int i = 0; i < 21; ++i) a.in[i] = (const float*)d_in[i];
    a.out = (float*)d_out; a.ws = (unsigned char*)d_ws;
#if MK_LAUNCH_PER_PHASE
    for (int p = 0; p < GP_TOTAL; ++p) { a.gp_lo = p; a.gp_hi = p + 1; hipLaunchKernelGGL(mk_fwd, dim3(grid), dim3(NWAVES * 64), LDS_BYTES, stream, a); }
#else
    a.gp_lo = 0; a.gp_hi = GP_TOTAL;
    hipLaunchKernelGGL(mk_fwd, dim3(grid), dim3(NWAVES * 64), LDS_BYTES, stream, a);
#endif
    const hipError_t le = hipPeekAtLastError();
    if (le != hipSuccess) fprintf(stderr, "kernel_launch: launch failed: %s\n", hipGetErrorName(le));
}
```

```cpp
#include <hip/hip_runtime.h>
#include <cstdio>
#include <cstdint>

#ifndef MOE_FP8
#define MOE_FP8 1
#endif
#ifndef H_BF16
#define H_BF16 1
#endif
#ifndef MK_LAUNCH_PER_PHASE
#define MK_LAUNCH_PER_PHASE 0
#endif

#define LAS __attribute__((address_space(3)))
#define GAS __attribute__((address_space(1)))
typedef unsigned short bf16;
typedef unsigned v4u __attribute__((ext_vector_type(4)));
typedef unsigned v2u __attribute__((ext_vector_type(2)));
typedef float f32x4 __attribute__((ext_vector_type(4)));
typedef float f32x2 __attribute__((ext_vector_type(2)));
typedef short bf16x8 __attribute__((ext_vector_type(8)));
typedef GAS unsigned gu32;
#define RLX_AGENT __ATOMIC_RELAXED, __HIP_MEMORY_SCOPE_AGENT
#define LDS_WAIT() asm volatile("s_waitcnt lgkmcnt(0)" ::: "memory")
#define VM_WAIT() asm volatile("s_waitcnt vmcnt(0)" ::: "memory")

constexpr int DM = 2048, NTOK = 16384, SEQ = 2048, NLAYER = 2;
constexpr int IN_DIM = 6672, NP = 6656;
constexpr int C_RQ = 0, C_RK = 512, C_RV = 1024, C_RG = 1536, C_SZ = 2048, C_SX = 3072, C_SB = 4096, C_SC = 4352, C_HQ = 4608, C_HF = 5120, C_HI = 5632, C_HG = 6144;
constexpr int DT_COL0 = 4608;
constexpr int NEXP = 32, DEXP = 512, CONVD = 1536;
constexpr int MAXTILES = 161, PADROWS = MAXTILES * 256;
constexpr float EPS = 1e-6f;

__host__ __device__ __forceinline__ size_t PB(size_t row, int col) { return ((size_t)(col >> 7) * NTOK + row) * 128 + (col & 127); }
__device__ __forceinline__ float bf2f(bf16 x) { return __uint_as_float(((unsigned)x) << 16); }
__device__ __forceinline__ unsigned f2bf(float f) { unsigned u = __float_as_uint(f); return (u + 0x7fffu + ((u >> 16) & 1u)) >> 16; }
typedef __bf16 bf16x2v __attribute__((ext_vector_type(2)));
__device__ __forceinline__ unsigned pk2(float lo, float hi) { const f32x2 v = {lo, hi}; return __builtin_bit_cast(unsigned, __builtin_convertvector(v, bf16x2v)); }
__device__ __forceinline__ bf16 f2bf1(float f) { return (bf16)pk2(f, f); }
__device__ __forceinline__ float siluf(float x) { return x * __builtin_amdgcn_rcpf(1.f + __expf(-x)); }
__device__ __forceinline__ float sigmf(float x) { return __builtin_amdgcn_rcpf(1.f + __expf(-x)); }
__device__ __forceinline__ float wave_sum(float v) {
#pragma unroll
    for (int o = 1; o < 64; o <<= 1) v += __shfl_xor(v, o);
    return v;
}

#define cvt2_fp8(a, b, old, hi) __builtin_amdgcn_cvt_pk_fp8_f32(__builtin_amdgcn_fmed3f((a), -448.f, 448.f), __builtin_amdgcn_fmed3f((b), -448.f, 448.f), (old), (hi))
namespace pg8 {
constexpr int BM = 256, BK = 64, HALF = 128, HTB = HALF * BK * 2, STAGE_BYTES = 8 * HTB, NXCD = 8, WGM = 8;
__host__ __device__ __forceinline__ int lds_byte(int r, int c) { const int st = (r >> 4) * 2 + (c >> 5), rr = r & 15, cc = c & 31, ob = rr * 64 + cc * 2; return st * 1024 + (ob ^ (((ob >> 9) & 1) << 5)); }
__host__ __device__ __forceinline__ void stage_rc(int b, int& R, int& C) { const int st = b / 1024, sb = b % 1024, swz = sb ^ (((sb >> 9) & 1) << 5); R = (st >> 1) * 16 + swz / 64; C = (st & 1) * 32 + (swz % 64) / 2; }
__host__ __device__ __forceinline__ int perm32(int rho) { const int n = rho >> 4, i = rho & 15; return 8 * (i >> 2) + 4 * n + (i & 3); }

struct Unit { int pm, pn, e, lt; };
struct Gemm { const bf16* A; const bf16* Bt; int M, N, K; unsigned wscale; };

struct StaticOrder {
    static constexpr bool GATHER = false;
    int nM, nN, nwg, G, c;
    __device__ void init(int M, int N, int G_, int c_) { nM = M / BM; nN = N / BM; nwg = nM * nN; G = G_; c = c_; }
    __device__ bool next(int i, Unit& u) const {
        const long L = (long)i * G + c; if (L >= nwg) return false;
        int wgid = (int)L; { const int q = nwg / NXCD, r = nwg % NXCD, xcd = wgid % NXCD, off = wgid / NXCD; wgid = (xcd < r ? xcd * (q + 1) : r * (q + 1) + (xcd - r) * q) + off; }
        const int nig = WGM * nN, gid = wgid / nig, fm = gid * WGM, gsz = (nM - fm) < WGM ? (nM - fm) : WGM;
        u.pm = fm + ((wgid % nig) % gsz); u.pn = (wgid % nig) / gsz; u.e = 0; u.lt = 0; return true;
    }
    __device__ __forceinline__ const char* a_base(const Gemm& g, const Unit& u) const { return (const char*)g.A + (size_t)u.pm * ((size_t)BM * g.K * 2); }
    __device__ __forceinline__ const char* b_base(const Gemm& g, const Unit& u) const { return (const char*)g.Bt + (size_t)u.pn * ((size_t)BM * g.K * 2); }
    __device__ __forceinline__ int gidx(int, int) const { return 0; }
};
template <bool GA> struct MoeOrder {
    static constexpr bool GATHER = GA;
    const LAS int* tmap; const LAS int* gtab; int ntiles, nN, G, c; size_t bstride;
    __device__ bool next(int i, Unit& u) const {
        const int L = i * G + c; if (L >= ntiles * nN) return false;
        const int mt = L / nN; const int v = tmap[mt]; u.pm = mt; u.pn = L - mt * nN; u.e = v >> 8; u.lt = v & 255; return true;
    }
    __device__ __forceinline__ const char* a_base(const Gemm& g, const Unit& u) const { return GA ? (const char*)g.A : (const char*)g.A + (size_t)u.pm * ((size_t)BM * g.K * 2); }
    __device__ __forceinline__ const char* b_base(const Gemm& g, const Unit& u) const { return (const char*)g.Bt + (size_t)u.e * bstride + (size_t)u.pn * ((size_t)BM * g.K * 2); }
    __device__ __forceinline__ int gidx(int ui, int r) const { return gtab[ui * 256 + r]; }
};

__device__ __forceinline__ unsigned cvt_pk_bf16(float lo, float hi) { return pk2(lo, hi); }

struct EpiBf16 {
    static constexpr bool PERM = true;
    bf16* O; int ldc;
    __device__ __forceinline__ void operator()(const f32x4 (&acc)[2][2][4][2], const Unit& u, int wr, int wc, int fr, int fq) const {
        const int row0 = u.pm * BM + wr * 64 + fr, col0 = u.pn * BM + wc * 32 + 8 * fq;
#pragma unroll
        for (int ai = 0; ai < 2; ++ai)
#pragma unroll
            for (int m = 0; m < 4; ++m) { bf16* rowp = O + (size_t)(row0 + ai * HALF + m * 16) * ldc + col0;
#pragma unroll
                for (int bj = 0; bj < 2; ++bj) { const f32x4 v0 = acc[ai][bj][m][0], v1 = acc[ai][bj][m][1];
                    v4u w; w.x = cvt_pk_bf16(v0[0], v0[1]); w.y = cvt_pk_bf16(v0[2], v0[3]); w.z = cvt_pk_bf16(v1[0], v1[1]); w.w = cvt_pk_bf16(v1[2], v1[3]);
                    *(v4u*)(rowp + bj * HALF) = w; } }
    }
};
struct EpiBf16Blk {
    static constexpr bool PERM = true;
    bf16* O; int M;
    __device__ __forceinline__ void operator()(const f32x4 (&acc)[2][2][4][2], const Unit& u, int wr, int wc, int fr, int fq) const {
        const int row0 = u.pm * BM + wr * 64 + fr, cin = wc * 32 + 8 * fq;
#pragma unroll
        for (int ai = 0; ai < 2; ++ai)
#pragma unroll
            for (int m = 0; m < 4; ++m) {
#pragma unroll
                for (int bj = 0; bj < 2; ++bj) { const f32x4 v0 = acc[ai][bj][m][0], v1 = acc[ai][bj][m][1];
                    v4u w; w.x = cvt_pk_bf16(v0[0], v0[1]); w.y = cvt_pk_bf16(v0[2], v0[3]); w.z = cvt_pk_bf16(v1[0], v1[1]); w.w = cvt_pk_bf16(v1[2], v1[3]);
                    *(v4u*)(O + ((size_t)(2 * u.pn + bj) * M + (row0 + ai * HALF + m * 16)) * 128 + cin) = w; } }
    }
};
struct EpiResF32 {
    static constexpr bool PERM = false;
    const float* res; float* out; int ldc;
    __device__ __forceinline__ void operator()(const f32x4 (&acc)[2][2][4][2], const Unit& u, int wr, int wc, int fr, int fq) const {
        const int row0 = u.pm * BM + wr * 64 + fr, col0 = u.pn * BM + wc * 32 + 4 * fq;
#pragma unroll
        for (int ai = 0; ai < 2; ++ai)
#pragma unroll
            for (int m = 0; m < 4; ++m) { const size_t off = (size_t)(row0 + ai * HALF + m * 16) * ldc + col0;
#pragma unroll
                for (int bj = 0; bj < 2; ++bj)
#pragma unroll
                    for (int n = 0; n < 2; ++n) { const f32x4 r = *(const f32x4*)(res + off + bj * HALF + n * 16); *(f32x4*)(out + off + bj * HALF + n * 16) = r + acc[ai][bj][m][n]; } }
    }
};
template <bool RES_F32> struct EpiResH {
    static constexpr bool PERM = true;
    const void* res; bf16* out; int ldc;
    __device__ __forceinline__ void operator()(const f32x4 (&acc)[2][2][4][2], const Unit& u, int wr, int wc, int fr, int fq) const {
        const int row0 = u.pm * BM + wr * 64 + fr, col0 = u.pn * BM + wc * 32 + 8 * fq;
#pragma unroll
        for (int ai = 0; ai < 2; ++ai)
#pragma unroll
            for (int m = 0; m < 4; ++m) { const size_t off = (size_t)(row0 + ai * HALF + m * 16) * ldc + col0;
#pragma unroll
                for (int bj = 0; bj < 2; ++bj) { f32x4 r0, r1;
                    if constexpr (RES_F32) { const float* rp = (const float*)res + off + bj * HALF; r0 = *(const f32x4*)rp; r1 = *(const f32x4*)(rp + 4); }
                    else { const v4u h_ = *(const v4u*)((const bf16*)res + off + bj * HALF);
                        r0 = (f32x4){__uint_as_float(h_.x << 16), __uint_as_float(h_.x & 0xffff0000u), __uint_as_float(h_.y << 16), __uint_as_float(h_.y & 0xffff0000u)};
                        r1 = (f32x4){__uint_as_float(h_.z << 16), __uint_as_float(h_.z & 0xffff0000u), __uint_as_float(h_.w << 16), __uint_as_float(h_.w & 0xffff0000u)}; }
                    const f32x4 v0 = r0 + acc[ai][bj][m][0], v1 = r1 + acc[ai][bj][m][1];
                    v4u w; w.x = cvt_pk_bf16(v0[0], v0[1]); w.y = cvt_pk_bf16(v0[2], v0[3]); w.z = cvt_pk_bf16(v1[0], v1[1]); w.w = cvt_pk_bf16(v1[2], v1[3]);
                    *(v4u*)(out + off + bj * HALF) = w; } }
    }
};
struct EpiSwiGlu {
    static constexpr bool PERM = true;
    bf16* H;
    __device__ __forceinline__ void operator()(const f32x4 (&acc)[2][2][4][2], const Unit& u, int wr, int wc, int fr, int fq) const {
        const int row0 = u.pm * BM + wr * 64 + fr, col0 = u.pn * 128 + wc * 32 + 8 * fq;
#pragma unroll
        for (int ai = 0; ai < 2; ++ai)
#pragma unroll
            for (int m = 0; m < 4; ++m) { bf16* rowp = H + (size_t)(row0 + ai * HALF + m * 16) * DEXP + col0;
                float o[8];
#pragma unroll
                for (int n = 0; n < 2; ++n)
#pragma unroll
                    for (int j = 0; j < 4; ++j) { const float g = acc[ai][0][m][n][j], up = acc[ai][1][m][n][j]; o[n * 4 + j] = (g * __builtin_amdgcn_rcpf(1.f + __expf(-g))) * up; }
                v4u w; w.x = cvt_pk_bf16(o[0], o[1]); w.y = cvt_pk_bf16(o[2], o[3]); w.z = cvt_pk_bf16(o[4], o[5]); w.w = cvt_pk_bf16(o[6], o[7]);
                *(v4u*)rowp = w; }
    }
};
struct EpiSwiGlu8 {
    static constexpr bool PERM = true;
    unsigned char* H;
    __device__ __forceinline__ void operator()(const f32x4 (&acc)[2][2][4][2], const Unit& u, int wr, int wc, int fr, int fq) const {
        const int row0 = u.pm * BM + wr * 64 + fr, col0 = u.pn * 128 + wc * 32 + 8 * fq;
#pragma unroll
        for (int ai = 0; ai < 2; ++ai)
#pragma unroll
            for (int m = 0; m < 4; ++m) { unsigned char* rowp = H + (size_t)(row0 + ai * HALF + m * 16) * DEXP + col0;
                float o[8];
#pragma unroll
                for (int n = 0; n < 2; ++n)
#pragma unroll
                    for (int j = 0; j < 4; ++j) { const float g = acc[ai][0][m][n][j], up = acc[ai][1][m][n][j]; o[n * 4 + j] = (g * __builtin_amdgcn_rcpf(1.f + __expf(-g))) * up; }
                int w0 = 0, w1 = 0;
                w0 = cvt2_fp8(o[0], o[1], w0, false); w0 = cvt2_fp8(o[2], o[3], w0, true);
                w1 = cvt2_fp8(o[4], o[5], w1, false); w1 = cvt2_fp8(o[6], o[7], w1, true);
                *(v2u*)rowp = (v2u){(unsigned)w0, (unsigned)w1}; }
    }
};
struct EpiScaleBf16 {
    static constexpr bool PERM = true;
    bf16* Y; int ldc; const float* wt; const LAS int* ecnt;
    __device__ __forceinline__ void operator()(const f32x4 (&acc)[2][2][4][2], const Unit& u, int wr, int wc, int fr, int fq) const {
        const int row0 = u.pm * BM + wr * 64 + fr, col0 = u.pn * BM + wc * 32 + 8 * fq;
        const int cnt = ecnt[u.e]; const float* wl = wt + (size_t)u.e * NTOK;
#pragma unroll
        for (int ai = 0; ai < 2; ++ai)
#pragma unroll
            for (int m = 0; m < 4; ++m) { const int lr = u.lt * 256 + wr * 64 + fr + ai * HALF + m * 16; const float s = lr < cnt ? wl[lr] : 0.f;
                bf16* rowp = Y + (size_t)(row0 + ai * HALF + m * 16) * ldc + col0;
#pragma unroll
                for (int bj = 0; bj < 2; ++bj) { const f32x4 v0 = acc[ai][bj][m][0] * s, v1 = acc[ai][bj][m][1] * s;
                    v4u w; w.x = cvt_pk_bf16(v0[0], v0[1]); w.y = cvt_pk_bf16(v0[2], v0[3]); w.z = cvt_pk_bf16(v1[0], v1[1]); w.w = cvt_pk_bf16(v1[2], v1[3]);
                    *(v4u*)(rowp + bj * HALF) = w; } }
    }
};

struct EpiScaleF8 {
    static constexpr bool PERM = true;
    unsigned char* Y; int ldc; const float* wt; const LAS int* ecnt;
    __device__ __forceinline__ void operator()(const f32x4 (&acc)[2][2][4][2], const Unit& u, int wr, int wc, int fr, int fq) const {
        const int row0 = u.pm * BM + wr * 64 + fr, col0 = u.pn * BM + wc * 32 + 8 * fq;
        const int cnt = ecnt[u.e]; const float* wl = wt + (size_t)u.e * NTOK;
#pragma unroll
        for (int ai = 0; ai < 2; ++ai)
#pragma unroll
            for (int m = 0; m < 4; ++m) { const int lr = u.lt * 256 + wr * 64 + fr + ai * HALF + m * 16; const float s = lr < cnt ? wl[lr] * 16.f : 0.f;
                unsigned char* rowp = Y + (size_t)(row0 + ai * HALF + m * 16) * ldc + col0;
#pragma unroll
                for (int bj = 0; bj < 2; ++bj) { const f32x4 v0 = acc[ai][bj][m][0] * s, v1 = acc[ai][bj][m][1] * s;
                    int w0 = 0, w1 = 0;
                    w0 = cvt2_fp8(v0[0], v0[1], w0, false); w0 = cvt2_fp8(v0[2], v0[3], w0, true);
                    w1 = cvt2_fp8(v1[0], v1[1], w1, false); w1 = cvt2_fp8(v1[2], v1[3], w1, true);
                    *(v2u*)(rowp + bj * HALF) = (v2u){(unsigned)w0, (unsigned)w1}; } }
    }
};

template <class Epi, class Sched, bool ALIGN_EPI, bool FP8 = false>
__device__ __forceinline__ void gemm_phase(LAS unsigned char* lds, const Gemm g, const Sched& S, const Epi& E) {
    constexpr bool GA = Sched::GATHER;
    int tid_ = threadIdx.x; asm volatile("" : "+v"(tid_));
    const int tid = tid_, wid = __builtin_amdgcn_readfirstlane(tid >> 6), lane = tid & 63, wr = wid >> 2, wc = wid & 3, fr = lane & 15, fq = lane >> 4;
    const int K = g.K, nt = K / BK;
    unsigned voffA[2], voffB[2], gC[2]; int gR[2];
#pragma unroll
    for (int i = 0; i < 2; ++i) { int R, C; stage_rc(tid * 16 + i * 8192, R, C); const int Rb = Epi::PERM ? ((R & ~31) + perm32(R & 31)) : R;
        voffA[i] = (unsigned)(R * K + C) * 2u; voffB[i] = (unsigned)(Rb * K + C) * 2u; gR[i] = R; gC[i] = (unsigned)C * 2u; }
    const size_t kstep = (size_t)(BK * 2);
    const size_t hstep = (size_t)HALF * K * 2;
    const size_t H1 = GA ? 0 : hstep;
    const unsigned ldsw = (unsigned)wid * 1024u;
    const int aoff = lds_byte(wr * 64 + fr, fq * 8), boff = lds_byte(wc * 32 + fr, fq * 8);
    unsigned vA0[2], vA1[2], vT1[2];
#define PG8_LOADG(ui_) do { int tg_ = threadIdx.x; asm volatile("" : "+v"(tg_)); _Pragma("unroll") for (int _i = 0; _i < 2; ++_i) { int R_, C_; stage_rc(tg_ * 16 + _i * 8192, R_, C_); vA0[_i] = (unsigned)S.gidx((ui_), R_) * (unsigned)(K * 2) + (unsigned)C_ * 2u; vA1[_i] = (unsigned)S.gidx((ui_), HALF + R_) * (unsigned)(K * 2) + (unsigned)C_ * 2u; } } while (0)
    unsigned (&rA0)[2] = GA ? vA0 : voffA; unsigned (&rA1)[2] = GA ? vA1 : voffA; unsigned (&rT1)[2] = GA ? vT1 : voffA;
#define PG8_SA(b, h) (((b) * 2 + (h)) * HTB)
#define PG8_SB(b, h) ((4 + (b) * 2 + (h)) * HTB)
#define PG8_STAGE(bufoff, gbase, voff) do { unsigned long long gb_ = (unsigned long long)(gbase); asm volatile("" : "+s"(gb_));     \
        _Pragma("unroll") for (int _i = 0; _i < 2; ++_i) { unsigned vo_ = (voff)[_i]; asm volatile("" : "+v"(vo_));     \
        __builtin_amdgcn_global_load_lds((const unsigned*)((const char*)gb_ + vo_), (LAS unsigned*)(lds + (bufoff) + ldsw + _i * 8192), 16, 0, 0); } } while (0)
#define PG8_LDA(dst, b, h) do { _Pragma("unroll") for (int m = 0; m < 4; ++m) { if constexpr (FP8) { \
            dst##8[m].lo = *(const LAS v4i_*)(lds + PG8_SA(b, h) + aoff + m * 2048); dst##8[m].hi = *(const LAS v4i_*)(lds + PG8_SA(b, h) + aoff + m * 2048 + 1024); } \
        else { _Pragma("unroll") for (int k = 0; k < 2; ++k) dst[m][k] = *(const LAS bf16x8*)(lds + PG8_SA(b, h) + aoff + m * 2048 + k * 1024); } } } while (0)
#define PG8_LDB(dst, b, h) do { _Pragma("unroll") for (int n = 0; n < 2; ++n) { if constexpr (FP8) { \
            dst##8[n].lo = *(const LAS v4i_*)(lds + PG8_SB(b, h) + boff + n * 2048); dst##8[n].hi = *(const LAS v4i_*)(lds + PG8_SB(b, h) + boff + n * 2048 + 1024); } \
        else { _Pragma("unroll") for (int k = 0; k < 2; ++k) dst[n][k] = *(const LAS bf16x8*)(lds + PG8_SB(b, h) + boff + n * 2048 + k * 1024); } } } while (0)
#define PG8_MMA(ai, bj, At, Bt) do { __builtin_amdgcn_s_setprio(1); _Pragma("unroll") for (int m = 0; m < 4; ++m) _Pragma("unroll") for (int n = 0; n < 2; ++n) { \
        if constexpr (FP8) asm volatile("v_mfma_scale_f32_16x16x128_f8f6f4 %0, %1, %2, %0, %3, %4 op_sel_hi:[0,0,0]" : "+v"(acc[ai][bj][m][n]) : "v"(Bt##8[n]), "v"(At##8[m]), "v"(wsc_), "v"(one_));     \
        else { _Pragma("unroll") for (int k = 0; k < 2; ++k) acc[ai][bj][m][n] = __builtin_amdgcn_mfma_f32_16x16x32_bf16(Bt[n][k], At[m][k], acc[ai][bj][m][n], 0, 0, 0); } } \
        __builtin_amdgcn_s_setprio(0); } while (0)
#define PG8_WAIT_V(n) asm volatile("s_waitcnt vmcnt(" #n ")" ::: "memory")
#define PG8_WAIT_L(n) asm volatile("s_waitcnt lgkmcnt(" #n ")" ::: "memory")
#define PG8_BAR __builtin_amdgcn_s_barrier()
#define PG8_SCHED __builtin_amdgcn_sched_barrier(0)
    Unit cur, nxt; int ui = 0;
    if (!S.next(0, cur)) return;
    f32x4 acc[2][2][4][2];
#pragma unroll
    for (int a = 0; a < 2; ++a)
#pragma unroll
        for (int b = 0; b < 2; ++b)
#pragma unroll
            for (int m = 0; m < 4; ++m)
#pragma unroll
                for (int n = 0; n < 2; ++n) acc[a][b][m][n] = (f32x4){0.f, 0.f, 0.f, 0.f};
    typedef int v8i_ __attribute__((ext_vector_type(8))); typedef int v4i_ __attribute__((ext_vector_type(4)));
    const int wsc_ = (int)g.wscale, one_ = 0x7f7f7f7f;
    bf16x8 At[4][2], B0[2][2], B1[2][2]; v8i_ At8[4], B08[2], B18[2];
    const char* cA = S.a_base(g, cur); const char* cB = S.b_base(g, cur);
    if constexpr (GA) { PG8_LOADG(0); vT1[0] = vA1[0]; vT1[1] = vA1[1]; }
    PG8_STAGE(PG8_SB(0, 0), cB, voffB); PG8_STAGE(PG8_SB(0, 1), cB + hstep, voffB); PG8_STAGE(PG8_SA(0, 0), cA, rA0); PG8_STAGE(PG8_SA(0, 1), cA + H1, rA1);
    if (wr == 1) PG8_BAR;
    PG8_WAIT_V(2); PG8_BAR;
    PG8_STAGE(PG8_SB(1, 0), cB + kstep, voffB); PG8_STAGE(PG8_SA(1, 0), cA + kstep, rA0); PG8_STAGE(PG8_SB(1, 1), cB + hstep + kstep, voffB);
    PG8_WAIT_V(6); PG8_BAR;
    for (;;) {
        const bool has_next = S.next(ui + 1, nxt);
        const char* nA = has_next ? S.a_base(g, nxt) : cA; const char* nB = has_next ? S.b_base(g, nxt) : cB;
#pragma unroll 1
        for (int t = 0; t < nt; t += 2) {
            const bool last = (t == nt - 2);
            const char* a1 = cA + (size_t)(t + 1) * kstep;
            const char* a2 = last ? nA : cA + (size_t)(t + 2) * kstep; const char* b2 = last ? nB : cB + (size_t)(t + 2) * kstep;
            const char* a3 = a2 + kstep; const char* b3 = b2 + kstep;
            if constexpr (GA) { if (last && has_next) PG8_LOADG(ui + 1); }
            PG8_LDB(B0, 0, 0); PG8_LDB(B1, 0, 1); PG8_SCHED; PG8_LDA(At, 0, 0); PG8_STAGE(PG8_SA(1, 1), a1 + H1, rT1);
            PG8_WAIT_V(8); PG8_WAIT_L(0); PG8_BAR; PG8_MMA(0, 0, At, B0); PG8_MMA(0, 1, At, B1); PG8_BAR; PG8_SCHED;
            PG8_LDA(At, 0, 1); PG8_STAGE(PG8_SB(0, 0), b2, voffB); PG8_STAGE(PG8_SB(0, 1), b2 + hstep, voffB); PG8_STAGE(PG8_SA(0, 0), a2, rA0);
            PG8_WAIT_V(8); PG8_WAIT_L(0); PG8_BAR; PG8_MMA(1, 0, At, B0); PG8_MMA(1, 1, At, B1); PG8_BAR; PG8_SCHED;
            PG8_LDB(B0, 1, 0); PG8_LDB(B1, 1, 1); PG8_SCHED; PG8_LDA(At, 1, 0); PG8_STAGE(PG8_SA(0, 1), a2 + H1, rA1);
            PG8_WAIT_V(8); PG8_WAIT_L(0); PG8_BAR; PG8_MMA(0, 0, At, B0); PG8_MMA(0, 1, At, B1); PG8_BAR; PG8_SCHED;
            PG8_LDA(At, 1, 1); PG8_STAGE(PG8_SB(1, 0), b3, voffB); PG8_STAGE(PG8_SB(1, 1), b3 + hstep, voffB); PG8_STAGE(PG8_SA(1, 0), a3, rA0);
            PG8_WAIT_V(8); PG8_WAIT_L(0); PG8_BAR; PG8_MMA(1, 0, At, B0); PG8_MMA(1, 1, At, B1); PG8_BAR; PG8_SCHED;
        }
        if constexpr (FP8) asm volatile("s_nop 15\n\ts_nop 15" ::: "memory");
        if constexpr (ALIGN_EPI) { if (wr == 0) PG8_BAR; }
        E(acc, cur, wr, wc, fr, fq);
        if (!has_next) break;
#pragma unroll
        for (int a = 0; a < 2; ++a)
#pragma unroll
            for (int b = 0; b < 2; ++b)
#pragma unroll
                for (int m = 0; m < 4; ++m)
#pragma unroll
                    for (int n = 0; n < 2; ++n) acc[a][b][m][n] = (f32x4){0.f, 0.f, 0.f, 0.f};
        cur = nxt; cA = nA; cB = nB; ++ui;
        if constexpr (GA) { vT1[0] = vA1[0]; vT1[1] = vA1[1]; }
        if constexpr (ALIGN_EPI) { if (wr == 1) PG8_BAR; }
    }
    PG8_WAIT_V(0);
    if constexpr (!ALIGN_EPI) { if (wr == 0) PG8_BAR; }
    PG8_BAR;
#undef PG8_LOADG
#undef PG8_SA
#undef PG8_SB
#undef PG8_STAGE
#undef PG8_LDA
#undef PG8_LDB
#undef PG8_MMA
#undef PG8_WAIT_V
#undef PG8_WAIT_L
#undef PG8_BAR
#undef PG8_SCHED
}
}

constexpr size_t MiB = 1u << 20;
constexpr size_t WS_CTL = 0, CTL_ZERO_BYTES = 1 * MiB;
constexpr size_t SZ_WIN = (size_t)NP * DM * 2, SZ_WDT = (size_t)16 * DM * 2, SZ_WR = (size_t)48 * DM * 2, SZ_WOUT = (size_t)DM * DM * 2;
constexpr size_t SZ_WGU1 = (size_t)1024 * DM * 2, SZ_WD1 = (size_t)DM * DEXP * 2;
constexpr size_t WS_WIN = 1 * MiB;
constexpr size_t WS_WDT = WS_WIN + NLAYER * SZ_WIN;
constexpr size_t WS_WR = WS_WDT + NLAYER * SZ_WDT;
constexpr size_t WS_WOUT = WS_WR + NLAYER * SZ_WR;
constexpr size_t WS_WGU = WS_WOUT + NLAYER * SZ_WOUT;
constexpr size_t WS_WD = WS_WGU + NLAYER * NEXP * SZ_WGU1;
constexpr size_t WS_P = WS_WD + NLAYER * NEXP * SZ_WD1;
constexpr size_t SZ_P = (size_t)NTOK * NP * 2;
constexpr size_t WS_Y = WS_P, SZ_Y = (size_t)PADROWS * DM * 2;
constexpr size_t WS_HID = WS_Y + SZ_Y, SZ_HID = (size_t)PADROWS * DEXP * 2;
static_assert(SZ_Y + SZ_HID <= SZ_P, "Y|HID overlay P");
constexpr size_t WS_U = WS_P + SZ_P, SZ_U = (size_t)NTOK * DM * 2;
constexpr size_t WS_DT = WS_U + SZ_U, SZ_DT = (size_t)NTOK * 16 * 4;
constexpr size_t WS_TOK = WS_DT + SZ_DT, SZ_TOK = (size_t)NEXP * NTOK * 4;
constexpr size_t WS_WT = WS_TOK + SZ_TOK;
constexpr size_t WS_SLOT = WS_WT + SZ_TOK, SZ_SLOT = (size_t)NTOK * 2 * 4;
constexpr size_t WS_ROT = WS_SLOT + SZ_SLOT, SZ_ROT = (size_t)SEQ * 64 * 4;
constexpr size_t WS_XC = WS_ROT + 2 * SZ_ROT, SZ_XC = (size_t)NTOK * CONVD * 2;
constexpr size_t HPU = 16384 + 16384 + 8192 + 512;
constexpr size_t WS_HP = WS_XC + SZ_XC, SZ_HP = (size_t)32 * 32 * HPU;
constexpr size_t WS_U8 = WS_XC;
constexpr size_t WS_SD = WS_HP + SZ_HP, SZ_SD = (size_t)8 * 16 * SEQ * 16;
constexpr size_t WS_H = WS_SD + SZ_SD, SZ_H = (size_t)NTOK * DM * 2;
constexpr size_t WS_END = WS_H + SZ_H;
static_assert(WS_END < 1000000000ull, "workspace map");
constexpr int CW_BAR = 4096;
constexpr int CW_CNT = 8192;
constexpr int RING_BYTES = 131072, LDSCTL_OFF = RING_BYTES, MISC_OFF = LDSCTL_OFF + 320;
constexpr int TAB_OFF = RING_BYTES + 1024;
constexpr int T_TMAP = 0, T_ECNT = 192, T_EBASE = 224, T_GTAB = 256, T_END = 256 + 1024;
constexpr int LDS_BYTES = 147456;
static_assert(TAB_OFF + T_END * 4 <= LDS_BYTES, "LDS map");
constexpr int NWAVES = 8;

#define XB_TMO      128
#define XB_XCNT(j)  (256  + 64 * (j))
#define XB_XSUB(j)  (1280 + 64 * (j))
#define XB_XGEN(j)  (2304 + 64 * (j))
#define XB_TOP      3328
#define XB_TOPGEN   3392
#define XCD_BAR_WORDS 3456
#define XB_SPIN_CAP (1u << 18)
__device__ __forceinline__ unsigned xb_ld(unsigned* p)              { return __hip_atomic_load(p, __ATOMIC_RELAXED, __HIP_MEMORY_SCOPE_AGENT); }
__device__ __forceinline__ unsigned xb_add(unsigned* p, unsigned v) { return __hip_atomic_fetch_add(p, v, __ATOMIC_RELAXED, __HIP_MEMORY_SCOPE_AGENT); }
__device__ __forceinline__ unsigned xb_xcc_id() { return (unsigned)__builtin_amdgcn_s_getreg((3 << 11) | 20) & 0xFu; }
#define XB_SPIN(cond, bar) do { unsigned _sp = 0; while (cond) { __builtin_amdgcn_s_sleep(1); \
    if ((++_sp & 255u) == 0u) { if (xb_ld(&(bar)[XB_TMO])) break; if (_sp > XB_SPIN_CAP) { atomicAdd(&(bar)[XB_TMO], 1u); break; } } } } while (0)
struct XcdBarrier { unsigned* bar; unsigned x; volatile LAS unsigned* st; };
__device__ __forceinline__ XcdBarrier xcd_barrier_post(unsigned* bar, volatile LAS unsigned* st) {
    XcdBarrier b; b.bar = bar; b.x = xb_xcc_id(); b.st = st;
    if (threadIdx.x == 0) (void)xb_add(&bar[XB_XCNT(b.x)], 1u);
    return b;
}
__device__ __forceinline__ void xcd_barrier_complete(unsigned* bar, unsigned x, unsigned& nloc, unsigned& nx) {
    const unsigned G = gridDim.x * gridDim.y * gridDim.z;
    unsigned sum, cnt, mine, sp = 0u;
    for (;;) {
        sum = 0u; cnt = 0u; mine = 0u;
#pragma unroll
        for (unsigned j = 0; j < 16; ++j) { const unsigned c = xb_ld(&bar[XB_XCNT(j)]); sum += c; cnt += (c > 0u) ? 1u : 0u; mine = (j == x) ? c : mine; }
        if (sum == G) break;
        __builtin_amdgcn_s_sleep(1);
        if ((++sp & 255u) == 0u) { if (xb_ld(&bar[XB_TMO])) break; if (sp > XB_SPIN_CAP) { atomicAdd(&bar[XB_TMO], 1u); break; } }
    }
    nloc = mine > 0u ? mine : 1u; nx = cnt > 0u ? cnt : 1u;
}
__device__ __forceinline__ void xcd_barrier(const XcdBarrier& b) {
    asm volatile("s_waitcnt vmcnt(0)" ::: "memory");
    __syncthreads();
    if (threadIdx.x == 0) {
        unsigned* bar = b.bar;
        __builtin_amdgcn_s_waitcnt(0);
        unsigned nloc = b.st[0], nx = b.st[1];
        if (nloc == 0u) { xcd_barrier_complete(bar, b.x, nloc, nx); b.st[0] = nloc; b.st[1] = nx; }
        const unsigned old = xb_add(&bar[XB_XSUB(b.x)], 1u);
        const unsigned gen = old / nloc;
        if (old + 1u == (gen + 1u) * nloc) {
            __builtin_amdgcn_fence(__ATOMIC_RELEASE, "agent");
            asm volatile("s_waitcnt vmcnt(0)" ::: "memory");
            const unsigned og = xb_add(&bar[XB_TOP], 1u);
            const unsigned tg = og / nx;
            if (og + 1u == (tg + 1u) * nx) xb_add(&bar[XB_TOPGEN], 1u);
            else XB_SPIN(xb_ld(&bar[XB_TOPGEN]) == tg, bar);
            __builtin_amdgcn_fence(__ATOMIC_ACQUIRE, "agent");
            xb_add(&bar[XB_XGEN(b.x)], 1u);
            asm volatile("s_waitcnt vmcnt(0)" ::: "memory");
        } else {
            XB_SPIN(xb_ld(&bar[XB_XGEN(b.x)]) == gen, bar);
            __builtin_amdgcn_fence(__ATOMIC_ACQUIRE, "agent");
            asm volatile("s_waitcnt vmcnt(0)" ::: "memory");
        }
    }
    __syncthreads();
}

struct Args { const float* in[21]; float* out; unsigned char* ws; int gp_lo, gp_hi; };
struct Frame {
    LAS unsigned char* lds;
    volatile LAS unsigned* MISC;
    LAS int* tab;
    unsigned* ctl;
    int tid, lane, wave, G, bid;
    float* out; unsigned char* ws;
};
enum { I_X = 0, I_ANW, I_WIN, I_CONVW, I_CONVB, I_DTB, I_ALOG, I_SSDD, I_SSDNW, I_HLB, I_HNW, I_WOUT, I_FNW, I_RGW, I_RGB, I_REW, I_REB, I_EWG, I_EWU, I_EWD, I_FINW };

__device__ __forceinline__ int gt0(const Frame& F) { return F.bid * (NWAVES * 64) + F.tid; }
struct TItem { const float* W; bf16* base; int N, K, kind, up, k0, n0; float sc; };
__device__ __forceinline__ bf16* titem_row(const TItem& t, int n) {
    if (n >= t.N) return nullptr;
    if (t.kind == 0) { if (n < DT_COL0) return t.base + (size_t)n * DM; if (n < DT_COL0 + 16) return nullptr; return t.base + (size_t)(n - 16) * DM; }
    if (t.kind == 1) return t.base + (size_t)n * t.K;
    return t.base + (size_t)((n >> 7) * 256 + t.up * 128 + (n & 127)) * DM;
}
constexpr int TI_IN = 32 * 209, TI_OUT = 32 * 64, TI_G = 32 * 16, TI_D = 8 * 64, TI_LAYER = TI_IN + TI_OUT + NEXP * (2 * TI_G + TI_D);
__device__ __forceinline__ void titem_decode(const Frame& F, const Args& A, int it, TItem& t) {
    const int l = it / TI_LAYER; int r = it - l * TI_LAYER; t.up = 0; t.sc = 1.f;
    if (r < TI_IN) { t.W = A.in[I_WIN] + (size_t)l * DM * IN_DIM; t.base = (bf16*)(F.ws + WS_WIN + l * SZ_WIN); t.N = IN_DIM; t.K = DM; t.kind = 0; }
    else if ((r -= TI_IN) < TI_OUT) { t.W = A.in[I_WOUT] + (size_t)l * DM * DM; t.base = (bf16*)(F.ws + WS_WOUT + l * SZ_WOUT); t.N = DM; t.K = DM; t.kind = 1; }
    else { r -= TI_OUT; const int e = r / (2 * TI_G + TI_D); r -= e * (2 * TI_G + TI_D); const size_t eo = (size_t)(l * NEXP + e);
        if (r < TI_G) { t.W = A.in[I_EWG] + eo * DM * DEXP; t.base = (bf16*)(F.ws + WS_WGU + eo * SZ_WGU1); t.N = DEXP; t.K = DM; t.kind = MOE_FP8 ? 3 : 2; t.sc = 64.f; }
        else if ((r -= TI_G) < TI_G) { t.W = A.in[I_EWU] + eo * DM * DEXP; t.base = (bf16*)(F.ws + WS_WGU + eo * SZ_WGU1); t.N = DEXP; t.K = DM; t.kind = MOE_FP8 ? 3 : 2; t.up = 1; t.sc = 64.f; }
        else { r -= TI_G; t.W = A.in[I_EWD] + eo * DEXP * DM; t.base = (bf16*)(F.ws + WS_WD + eo * SZ_WD1); t.N = DM; t.K = DEXP; t.kind = MOE_FP8 ? 4 : 1; t.sc = 32.f; } }
    const int nblk = (t.N + 31) / 32, kb = r / nblk, nb = r - kb * nblk; t.k0 = 64 * kb; t.n0 = 32 * nb;
}
__device__ __forceinline__ void titem_load(const TItem& t, f32x4 (&v)[8], int lane) {
    const int kq = lane >> 3, nc = t.n0 + 4 * (lane & 7); const bool ok = nc < t.N;
#pragma unroll
    for (int j = 0; j < 8; ++j) v[j] = ok ? *(const f32x4*)(t.W + (size_t)(t.k0 + kq + 8 * j) * t.N + nc) : (f32x4){0.f, 0.f, 0.f, 0.f};
}
__device__ __forceinline__ void titem_store(const TItem& t, const f32x4 (&v)[8], LAS float* scr, int lane) {
    const int kq = lane >> 3, c4 = lane & 7;
#pragma unroll
    for (int j = 0; j < 8; ++j)
#pragma unroll
        for (int e = 0; e < 4; ++e) scr[(kq + 8 * j) * 33 + 4 * c4 + e] = v[j][e];
    LDS_WAIT(); asm volatile("" ::: "memory");
    if (t.kind >= 3) {
        const int n = lane & 31, hf = lane >> 5; const LAS float* s = scr + (32 * hf) * 33 + n; v4u o[2];
#pragma unroll
        for (int q = 0; q < 8; ++q) { int w_ = 0;
            w_ = cvt2_fp8(s[(4 * q + 0) * 33] * t.sc, s[(4 * q + 1) * 33] * t.sc, w_, false);
            w_ = cvt2_fp8(s[(4 * q + 2) * 33] * t.sc, s[(4 * q + 3) * 33] * t.sc, w_, true);
            o[q >> 2][q & 3] = (unsigned)w_; }
        const int nn = t.n0 + n;
        if (nn < t.N) { unsigned char* dst = (unsigned char*)t.base + (t.kind == 3 ? (size_t)((nn >> 7) * 256 + t.up * 128 + (nn & 127)) * DM : (size_t)nn * t.K) + t.k0 + 32 * hf;
            *(v4u*)dst = o[0]; *(v4u*)(dst + 16) = o[1]; }
        LDS_WAIT(); asm volatile("" ::: "memory");
        return;
    }
    const int c = lane & 7;
#pragma unroll
    for (int j = 0; j < 4; ++j) { const int n = (lane >> 3) + 8 * j; const LAS float* s = scr + (8 * c) * 33 + n;
        v4u o; o.x = pk2(s[0 * 33], s[1 * 33]); o.y = pk2(s[2 * 33], s[3 * 33]); o.z = pk2(s[4 * 33], s[5 * 33]); o.w = pk2(s[6 * 33], s[7 * 33]);
        bf16* dst = titem_row(t, t.n0 + n); if (dst) *(v4u*)(dst + t.k0 + 8 * c) = o; }
    LDS_WAIT(); asm volatile("" ::: "memory");
}
#ifndef CONV_SPLIT_ITEMS
#define CONV_SPLIT_ITEMS 20000
#endif
constexpr int CONV_SPLIT = CONV_SPLIT_ITEMS;
#ifndef CT_ITEMS
#define CT_ITEMS 20000
#endif
constexpr int CT_LO = NLAYER * (32 * 209 + 32 * 64 + NEXP * (2 * 32 * 16 + 8 * 64)) - CT_ITEMS;
constexpr int G1_WGS = 192;
static_assert(CONV_SPLIT >= TI_IN && CONV_SPLIT <= NLAYER * TI_LAYER, "conversion split");
__device__ __forceinline__ void convert_items(Frame& F, const Args& A, int lo, int hi, int gw, int NGW) {
    LAS float* scr = (LAS float*)(F.lds + F.wave * 16384);
    for (int it = lo + gw; it < hi; it += 4 * NGW) {
        TItem t0, t1, t2, t3; f32x4 v0[8], v1[8], v2[8], v3[8];
        const bool h1 = it + NGW < hi, h2 = it + 2 * NGW < hi, h3 = it + 3 * NGW < hi;
        titem_decode(F, A, it, t0); titem_load(t0, v0, F.lane);
        if (h1) { titem_decode(F, A, it + NGW, t1); titem_load(t1, v1, F.lane); }
        if (h2) { titem_decode(F, A, it + 2 * NGW, t2); titem_load(t2, v2, F.lane); }
        if (h3) { titem_decode(F, A, it + 3 * NGW, t3); titem_load(t3, v3, F.lane); }
        titem_store(t0, v0, scr, F.lane);
        if (h1) titem_store(t1, v1, scr, F.lane);
        if (h2) titem_store(t2, v2, scr, F.lane);
        if (h3) titem_store(t3, v3, scr, F.lane);
    }
}
__device__ __forceinline__ void phase_prologue(Frame& F, const Args& A) {
    const int gw = F.bid * NWAVES + F.wave, NGW = F.G * NWAVES;
    convert_items(F, A, 0, CONV_SPLIT, gw, NGW);
    for (int i = gt0(F); i < SEQ * 64; i += F.G * NWAVES * 64) { const int pos = i >> 6, ri = i & 63; float sn, cs; sincosf((float)pos * powf(10000.f, -(float)ri / 64.f), &sn, &cs);
        ((float*)(F.ws + WS_ROT))[i] = cs; ((float*)(F.ws + WS_ROT + SZ_ROT))[i] = sn; }
    const int gt = F.bid * (NWAVES * 64) + F.tid, NGT = F.G * NWAVES * 64;
    for (int i = gt; i < NLAYER * 16 * DM; i += NGT) { const int l = i / (16 * DM), j = (i / DM) % 16, k = i % DM;
        ((bf16*)(F.ws + WS_WDT))[i] = (bf16)f2bf(A.in[I_WIN][(size_t)l * DM * IN_DIM + (size_t)k * IN_DIM + DT_COL0 + j]); }
    for (int i = gt; i < NLAYER * 48 * DM; i += NGT) { const int l = i / (48 * DM), j = (i / DM) % 48, k = i % DM;
        float v = 0.f; if (j < 4) v = A.in[I_RGW][((size_t)l * DM + k) * 4 + j]; else if (j < 36) v = A.in[I_REW][((size_t)l * DM + k) * 32 + (j - 4)];
        ((bf16*)(F.ws + WS_WR))[i] = (bf16)f2bf(v); }
}

template <int NCT>
__device__ __forceinline__ void mini_gemm16(const bf16* A, const bf16* Bt, f32x4 (&acc)[NCT], int lane) {
    const int fr = lane & 15, fq = lane >> 4;
#pragma unroll
    for (int c = 0; c < NCT; ++c) acc[c] = (f32x4){0.f, 0.f, 0.f, 0.f};
    const bf16* ap = A + (size_t)fr * DM + fq * 8; const bf16* bp = Bt + (size_t)fr * DM + fq * 8;
#pragma unroll 4
    for (int ks = 0; ks < DM / 32; ++ks) {
        const bf16x8 a = *(const bf16x8*)(ap + ks * 32);
#pragma unroll
        for (int c = 0; c < NCT; ++c) { const bf16x8 b = *(const bf16x8*)(bp + (size_t)c * 16 * DM + ks * 32); acc[c] = __builtin_amdgcn_mfma_f32_16x16x32_bf16(a, b, acc[c], 0, 0, 0); }
    }
}

__device__ __forceinline__ void build_tables(Frame& F, int l) {
    if (F.tid == 0) { int run = 0;
        for (int e = 0; e < NEXP; ++e) { const int c = (int)__hip_atomic_load(F.ctl + CW_CNT + (l * NEXP + e) * 64, RLX_AGENT); const int nt = (c + 255) >> 8;
            F.tab[T_ECNT + e] = c; F.tab[T_EBASE + e] = run; for (int t = 0; t < nt; ++t) F.tab[T_TMAP + run + t] = (e << 8) | t; run += nt; }
        F.MISC[16] = (unsigned)run; }
    __syncthreads();
}

template <int MODE, int NR, bool F8 = false, bool HB = false>
__device__ __forceinline__ void norm_rows(const float* const (&src)[NR], float* const (&hdst)[NR], const bf16* const (&y0)[NR], const bf16* const (&y1)[NR], const f32x4 (&wv)[8], bf16* const (&udst)[NR], float* const (&fdst)[NR], int lane, unsigned char* const* u8 = nullptr) {
    f32x4 v[NR][8];
#pragma unroll
    for (int q = 0; q < NR; ++q)
#pragma unroll
        for (int j = 0; j < 8; ++j) { if constexpr (HB) { const v2u h_ = ((const v2u*)src[q] + lane)[64 * j]; v[q][j] = (f32x4){__uint_as_float(h_.x << 16), __uint_as_float(h_.x & 0xffff0000u), __uint_as_float(h_.y << 16), __uint_as_float(h_.y & 0xffff0000u)}; }
            else v[q][j] = ((const f32x4*)src[q] + lane)[64 * j]; }
    if (MODE >= 1) {
#pragma unroll
        for (int q = 0; q < NR; ++q) {
#if MOE_FP8
            unsigned ya[8], yb[8];
#pragma unroll
            for (int j = 0; j < 8; ++j) { ya[j] = *((const unsigned*)y0[q] + lane + 64 * j); yb[j] = *((const unsigned*)y1[q] + lane + 64 * j); }
#pragma unroll
            for (int j = 0; j < 8; ++j) { const f32x2 a0 = __builtin_amdgcn_cvt_pk_f32_fp8((int)ya[j], false), a1 = __builtin_amdgcn_cvt_pk_f32_fp8((int)ya[j], true), b0 = __builtin_amdgcn_cvt_pk_f32_fp8((int)yb[j], false), b1 = __builtin_amdgcn_cvt_pk_f32_fp8((int)yb[j], true);
                v[q][j][0] += (a0.x + b0.x) * 0.0625f; v[q][j][1] += (a0.y + b0.y) * 0.0625f; v[q][j][2] += (a1.x + b1.x) * 0.0625f; v[q][j][3] += (a1.y + b1.y) * 0.0625f; }
#else
            v2u ya[8], yb[8];
#pragma unroll
            for (int j = 0; j < 8; ++j) { ya[j] = *((const v2u*)y0[q] + lane + 64 * j); yb[j] = *((const v2u*)y1[q] + lane + 64 * j); }
#pragma unroll
            for (int j = 0; j < 8; ++j) { const v2u a = ya[j], b = yb[j];
                v[q][j][0] += __uint_as_float(a.x << 16) + __uint_as_float(b.x << 16); v[q][j][1] += __uint_as_float(a.x & 0xffff0000u) + __uint_as_float(b.x & 0xffff0000u);
                v[q][j][2] += __uint_as_float(a.y << 16) + __uint_as_float(b.y << 16); v[q][j][3] += __uint_as_float(a.y & 0xffff0000u) + __uint_as_float(b.y & 0xffff0000u); }
#endif
        }
    }
#pragma unroll
    for (int q = 0; q < NR; ++q) {
        if (MODE == 1) {
#pragma unroll
            for (int j = 0; j < 8; ++j) { if constexpr (HB) { v2u p; p.x = pk2(v[q][j][0], v[q][j][1]); p.y = pk2(v[q][j][2], v[q][j][3]); ((v2u*)hdst[q] + lane)[64 * j] = p;
                    v[q][j] = (f32x4){__uint_as_float(p.x << 16), __uint_as_float(p.x & 0xffff0000u), __uint_as_float(p.y << 16), __uint_as_float(p.y & 0xffff0000u)}; }
                else ((f32x4*)hdst[q] + lane)[64 * j] = v[q][j]; }
        }
        float s = 0.f;
#pragma unroll
        for (int j = 0; j < 8; ++j) s += (v[q][j][0] * v[q][j][0] + v[q][j][1] * v[q][j][1]) + (v[q][j][2] * v[q][j][2] + v[q][j][3] * v[q][j][3]);
        const float rstd = 1.f / sqrtf(wave_sum(s) * (1.f / DM) + EPS);
#pragma unroll
        for (int j = 0; j < 8; ++j) { const f32x4 o = v[q][j] * rstd * wv[j];
            if (MODE == 2) ((f32x4*)fdst[q] + lane)[64 * j] = o;
            else { v2u p; p.x = pk2(o[0], o[1]); p.y = pk2(o[2], o[3]); ((v2u*)udst[q] + lane)[64 * j] = p;
                if constexpr (F8) { int w_ = 0; w_ = cvt2_fp8(o[0], o[1], w_, false); w_ = cvt2_fp8(o[2], o[3], w_, true); ((unsigned*)u8[q] + lane)[64 * j] = (unsigned)w_; } } }
    }
}
__device__ __forceinline__ void load_normw(const float* w, f32x4 (&wv)[8], int lane) {
#pragma unroll
    for (int j = 0; j < 8; ++j) wv[j] = ((const f32x4*)w + lane)[64 * j];
}

__device__ __forceinline__ void phase_norm1(Frame& F, const Args& A, int l) {
    bf16* U = (bf16*)(F.ws + WS_U); const bf16* Y = (const bf16*)(F.ws + WS_Y); const int* slot = (const int*)(F.ws + WS_SLOT);
    f32x4 wv[8]; load_normw(A.in[I_ANW] + l * DM, wv, F.lane);
    if (l > 0) build_tables(F, l - 1);
    for (int blk = F.bid; blk < NTOK / 64; blk += F.G) {
        const int row0 = blk * 64;
        for (int r = 0; r < 8; r += 2) { const int row = row0 + F.wave * 8 + r;
            const float* src[2]; float* hd[2]; const bf16* ya[2]; const bf16* yb[2]; bf16* ud[2]; float* fd[2] = {nullptr, nullptr};
#pragma unroll
            for (int q = 0; q < 2; ++q) { const int rw = row + q; ud[q] = U + (size_t)rw * DM;
                if (l == 0) { src[q] = A.in[I_X] + (size_t)rw * DM; hd[q] = nullptr; ya[q] = nullptr; yb[q] = nullptr; }
                else { const int s0 = slot[rw * 2], s1 = slot[rw * 2 + 1];
                    ya[q] = Y + ((size_t)F.tab[T_EBASE + (s0 >> 16)] * 256 + (s0 & 0xffff)) * (MOE_FP8 ? DM / 2 : DM); yb[q] = Y + ((size_t)F.tab[T_EBASE + (s1 >> 16)] * 256 + (s1 & 0xffff)) * (MOE_FP8 ? DM / 2 : DM);
                    src[q] = H_BF16 ? (const float*)((const bf16*)(F.ws + WS_H) + (size_t)rw * DM) : F.out + (size_t)rw * DM; hd[q] = H_BF16 ? (float*)((bf16*)(F.ws + WS_H) + (size_t)rw * DM) : F.out + (size_t)rw * DM; } }
            if (l == 0) norm_rows<0, 2>(src, hd, ya, yb, wv, ud, fd, F.lane); else norm_rows<1, 2, false, H_BF16>(src, hd, ya, yb, wv, ud, fd, F.lane);
        }
        VM_WAIT(); __syncthreads();
        if (F.wave < 4) { f32x4 acc[1]; const int rb = row0 + F.wave * 16;
            mini_gemm16<1>(U + (size_t)rb * DM, (const bf16*)(F.ws + WS_WDT + l * SZ_WDT), acc, F.lane);
            float* DT = (float*)(F.ws + WS_DT);
#pragma unroll
            for (int j = 0; j < 4; ++j) DT[(size_t)(rb + (F.lane >> 4) * 4 + j) * 16 + (F.lane & 15)] = acc[0][j]; }
    }
}

__device__ __forceinline__ void phase_norm2(Frame& F, const Args& A, int l) {
    bf16* U = (bf16*)(F.ws + WS_U); f32x4 wv[8]; load_normw(A.in[I_FNW] + l * DM, wv, F.lane);
    LAS float* lg = (LAS float*)F.lds;
    LAS int* s_e = (LAS int*)(F.lds + 16384); LAS float* s_w = (LAS float*)(F.lds + 16384 + 512); LAS int* s_rank = (LAS int*)(F.lds + 16384 + 1024);
    LAS int* lcnt = (LAS int*)(F.lds + 16384 + 1536); LAS int* lbase = (LAS int*)(F.lds + 16384 + 1664);
    int* tokl = (int*)(F.ws + WS_TOK); float* wtl = (float*)(F.ws + WS_WT); int* slot = (int*)(F.ws + WS_SLOT);
    for (int blk = F.bid; blk < NTOK / 64; blk += F.G) {
        const int row0 = blk * 64;
        for (int r = 0; r < 8; r += 2) { const int row = row0 + F.wave * 8 + r;
            const float* src[2] = {H_BF16 ? (const float*)((const bf16*)(F.ws + WS_H) + (size_t)row * DM) : F.out + (size_t)row * DM, H_BF16 ? (const float*)((const bf16*)(F.ws + WS_H) + (size_t)(row + 1) * DM) : F.out + (size_t)(row + 1) * DM}; float* hd[2] = {nullptr, nullptr}; const bf16* ya[2] = {nullptr, nullptr};
            bf16* ud[2] = {U + (size_t)row * DM, U + (size_t)(row + 1) * DM}; float* fd[2] = {nullptr, nullptr};
            unsigned char* u8[2] = {F.ws + WS_U8 + (size_t)row * DM, F.ws + WS_U8 + (size_t)(row + 1) * DM};
            if (MOE_FP8) norm_rows<0, 2, true, H_BF16>(src, hd, ya, ya, wv, ud, fd, F.lane, u8); else norm_rows<0, 2, false, H_BF16>(src, hd, ya, ya, wv, ud, fd, F.lane); }
        if (F.tid < 32) lcnt[F.tid] = 0;
        VM_WAIT(); __syncthreads();
        if (F.wave < 4) { f32x4 acc[3]; const int rb = F.wave * 16;
            mini_gemm16<3>(U + (size_t)(row0 + rb) * DM, (const bf16*)(F.ws + WS_WR + l * SZ_WR), acc, F.lane);
#pragma unroll
            for (int c = 0; c < 3; ++c)
#pragma unroll
                for (int j = 0; j < 4; ++j) lg[(rb + (F.lane >> 4) * 4 + j) * 48 + c * 16 + (F.lane & 15)] = acc[c][j]; }
        __syncthreads();
        if (F.tid < 64) { const LAS float* L = lg + F.tid * 48;
            const float* bg = A.in[I_RGB] + l * 4; const float* be = A.in[I_REB] + l * 32;
            float gl[4]; int g = 0;
#pragma unroll
            for (int j = 0; j < 4; ++j) gl[j] = L[j] + bg[j];
#pragma unroll
            for (int j = 1; j < 4; ++j) if (gl[j] > gl[g]) g = j;
            float den = 0.f;
#pragma unroll
            for (int j = 0; j < 4; ++j) den += __expf(gl[j] - gl[g]);
            const float gate = 1.f / den;
            float el[8];
#pragma unroll
            for (int j = 0; j < 8; ++j) el[j] = L[4 + g * 8 + j] + be[g * 8 + j];
            int i1 = 0;
#pragma unroll
            for (int j = 1; j < 8; ++j) if (el[j] > el[i1]) i1 = j;
            int i2 = (i1 == 0) ? 1 : 0;
#pragma unroll
            for (int j = 0; j < 8; ++j) if (j != i1 && el[j] > el[i2]) i2 = j;
            const float w1 = gate / (1.f + __expf(el[i2] - el[i1])), w2 = gate - w1;
            s_e[2 * F.tid] = g * 8 + i1; s_e[2 * F.tid + 1] = g * 8 + i2; s_w[2 * F.tid] = w1; s_w[2 * F.tid + 1] = w2; }
        __syncthreads();
        if (F.tid < 128) s_rank[F.tid] = __hip_atomic_fetch_add(lcnt + s_e[F.tid], 1, __ATOMIC_RELAXED, __HIP_MEMORY_SCOPE_WORKGROUP);
        __syncthreads();
        if (F.tid < 32) { const int c = lcnt[F.tid]; lbase[F.tid] = c ? (int)__hip_atomic_fetch_add(F.ctl + CW_CNT + (l * NEXP + F.tid) * 64, (unsigned)c, RLX_AGENT) : 0; }
        __syncthreads();
        if (F.tid < 128) { const int e = s_e[F.tid], pos = lbase[e] + s_rank[F.tid], tok = row0 + (F.tid >> 1);
            tokl[(size_t)e * NTOK + pos] = tok; wtl[(size_t)e * NTOK + pos] = s_w[F.tid]; slot[tok * 2 + (F.tid & 1)] = (e << 16) | pos; }
        __syncthreads();
    }
}

enum { MX_RET = 0, MX_SSD = 1, MX_HGRN = 2 };
constexpr int IM_QA = 0, IM_QB = 16384, IM_KB = 32768, IM_KS = 73728, IM_V = 90112, IM_VS = 98304, IM_P = 106496, IM_ST = 114688;
constexpr int SM_CUM = TAB_OFF + T_END * 4, SM_TOT = SM_CUM + 512, SM_LAST = SM_TOT + 2048, SM_CW = SM_LAST + 512, SM_END = SM_CW + 6400;
static_assert(IM_ST + 16384 <= RING_BYTES && SM_END <= LDS_BYTES, "mixer LDS map");
typedef short s16x4 __attribute__((ext_vector_type(4)));
__device__ __forceinline__ unsigned img256(unsigned r, unsigned ch) { return 256u * r + 16u * (ch ^ (((r & 3u) << 2) | ((r >> 2) & 3u))); }
__device__ __forceinline__ unsigned imgP(unsigned r, unsigned ch) { return 128u * r + 16u * (ch ^ ((r >> 1) & 7u)); }
__device__ __forceinline__ unsigned imgV(unsigned r, unsigned ch) { return 128u * r + 16u * (ch ^ ((((r >> 1) & 1u) | (((r >> 3) & 1u) << 1)) << 1)); }
__device__ __forceinline__ bf16x8 tr_pair(LAS unsigned char* base, unsigned a0, unsigned a1) {
    const s16x4 lo = __builtin_amdgcn_ds_read_tr16_b64_v4i16((LAS s16x4*)(base + a0));
    const s16x4 hi = __builtin_amdgcn_ds_read_tr16_b64_v4i16((LAS s16x4*)(base + a1));
    return __builtin_shufflevector(lo, hi, 0, 1, 2, 3, 4, 5, 6, 7);
}
__device__ __forceinline__ void unpack8(const v4u x, float (&f)[8]) {
    f[0] = __uint_as_float(x.x << 16); f[1] = __uint_as_float(x.x & 0xffff0000u); f[2] = __uint_as_float(x.y << 16); f[3] = __uint_as_float(x.y & 0xffff0000u);
    f[4] = __uint_as_float(x.z << 16); f[5] = __uint_as_float(x.z & 0xffff0000u); f[6] = __uint_as_float(x.w << 16); f[7] = __uint_as_float(x.w & 0xffff0000u); }
__device__ __forceinline__ v4u pack8(const float (&f)[8]) { v4u w; w.x = pk2(f[0], f[1]); w.y = pk2(f[2], f[3]); w.z = pk2(f[4], f[5]); w.w = pk2(f[6], f[7]); return w; }


__device__ __forceinline__ void phase_conv(Frame& F, const Args& A, int l) {
    const bf16* P = (const bf16*)(F.ws + WS_P); bf16* XC = (bf16*)(F.ws + WS_XC);
    const float* cw = A.in[I_CONVW] + l * 4 * CONVD; const float* cb = A.in[I_CONVB] + l * CONVD;
    const int gt = F.bid * (NWAVES * 64) + F.tid, NGT = F.G * NWAVES * 64;
    for (int it = gt; it < (NTOK / 16) * 192; it += NGT) {
        const int rb = it / 192, cch = it - rb * 192, ch0 = cch * 8, row0 = rb * 16, tseq = row0 & (SEQ - 1);
        float cwr[4][8], cbr[8];
#pragma unroll
        for (int j = 0; j < 4; ++j) { const f32x4 a0 = *(const f32x4*)(cw + j * CONVD + ch0), a1 = *(const f32x4*)(cw + j * CONVD + ch0 + 4);
#pragma unroll
            for (int e = 0; e < 4; ++e) { cwr[j][e] = a0[e]; cwr[j][4 + e] = a1[e]; } }
        { const f32x4 b0 = *(const f32x4*)(cb + ch0), b1 = *(const f32x4*)(cb + ch0 + 4);
#pragma unroll
            for (int e = 0; e < 4; ++e) { cbr[e] = b0[e]; cbr[4 + e] = b1[e]; } }
        v4u xr[19];
#pragma unroll
        for (int rr = 0; rr < 19; ++rr) xr[rr] = (tseq + rr - 3 >= 0) ? *(const v4u*)(P + PB((size_t)(row0 + rr - 3), C_SX + ch0)) : (v4u){0u, 0u, 0u, 0u};
        float xs[4][8];
        unpack8(xr[0], xs[0]); unpack8(xr[1], xs[1]); unpack8(xr[2], xs[2]);
#pragma unroll
        for (int e = 0; e < 16; ++e) { float acc[8];
            unpack8(xr[e + 3], xs[(e + 3) & 3]);
#pragma unroll
            for (int c = 0; c < 8; ++c) acc[c] = cbr[c];
#pragma unroll
            for (int j = 0; j < 4; ++j)
#pragma unroll
                for (int c = 0; c < 8; ++c) acc[c] = fmaf(cwr[j][c], xs[(e + j) & 3][c], acc[c]);
#pragma unroll
            for (int c = 0; c < 8; ++c) acc[c] = siluf(acc[c]);
            *(v4u*)(XC + (size_t)(row0 + e) * CONVD + ch0) = pack8(acc); }
    }
}
#define IM_HCOPY(p) ((p) < 1024 ? IM_QB + (p) * 16 : ((p) < 2048 ? IM_KS + ((p) - 1024) * 16 : IM_P + ((p) - 2048) * 16))
#define MIX_BAR() do { asm volatile("s_waitcnt lgkmcnt(0)" ::: "memory"); __builtin_amdgcn_s_barrier(); asm volatile("" ::: "memory"); } while (0)

__device__ __forceinline__ void hgrn_prep_unit(Frame& F, const Args& A, int l, int b, int h, int n) {
    LAS unsigned char* lds = F.lds;
    const bf16* P = (const bf16*)(F.ws + WS_P);
    LAS float* totv = (LAS float*)(lds + SM_TOT); LAS float* lastv = (LAS float*)(lds + SM_LAST);
    const int tid = F.tid, w = F.wave;
    int lz = F.lane; asm volatile("" : "+v"(lz));
    const int fr = lz & 15, g = lz >> 4;
    const int ia = w >> 1, cc0 = (w & 1) * 2;
    const size_t row0 = (size_t)b * SEQ + n * 64;
    const int kk = tid & 127, sa = w >> 1;
    float hlb = 0.f;
    if (l > 0) { const float x0 = A.in[I_HLB][h * 128 + kk], x1 = A.in[I_HLB][512 + h * 128 + kk]; hlb = __builtin_amdgcn_rcpf(1.f + __expf(x0 - x1)); }
    const float hlbf = fmaxf(hlb, 1e-30f);
    bf16 hq[16], hf[16];
#pragma unroll
    for (int r = 0; r < 16; ++r) { const size_t pr_ = row0 + 16 * sa + r; hq[r] = P[PB(pr_, C_HQ + h * 128 + kk)]; hf[r] = P[PB(pr_, C_HF + h * 128 + kk)]; }
    float qv[16], kv[16], plr[16]; float pl = 1.f;
#pragma unroll
    for (int r = 0; r < 16; ++r) {
        const float qx = bf2f(hq[r]), fx = bf2f(hf[r]);
        const float sg = sigmf(fx);
        qv[r] = siluf(qx) * 0.08838834764831845f; kv[r] = (1.f - hlb) * (1.f - sg); pl *= hlbf + (1.f - hlb) * sg; plr[r] = pl; }
    totv[sa * 128 + kk] = pl;
    MIX_BAR();
    const float tt0 = totv[kk], tt1 = totv[128 + kk], tt2 = totv[256 + kk], tt3 = totv[384 + kk];
    if (sa == 0) lastv[kk] = tt0 * tt1 * tt2 * tt3;
    const float Ra = sa == 0 ? 1.f : (sa == 1 ? tt0 : (sa == 2 ? tt0 * tt1 : tt0 * tt1 * tt2));
    const float Ua = sa == 0 ? tt0 * tt1 * tt2 * tt3 : (sa == 1 ? tt1 * tt2 * tt3 : (sa == 2 ? tt2 * tt3 : tt3));
    const unsigned cb2 = (unsigned)(kk & 7) * 2u, chk = (unsigned)kk >> 3;
#pragma unroll
    for (int r = 0; r < 16; ++r) { const unsigned t = 16 * sa + r; const float qa = qv[r] * plr[r], ik = kv[r] * __builtin_amdgcn_rcpf(fmaxf(plr[r], 1e-30f));
        *(LAS bf16*)(lds + IM_QA + img256(t, chk) + cb2) = f2bf1(qa);
        *(LAS bf16*)(lds + IM_QB + img256(t, chk) + cb2) = f2bf1(qa * Ra);
        *(LAS bf16*)(lds + IM_KS + img256(t, chk) + cb2) = f2bf1(ik * Ua);
        float m = 1.f;
#pragma unroll
        for (int ap = 0; ap < 4; ++ap) if (ap >= sa) {
            if (ap > sa) m *= (ap == 1 ? tt0 : (ap == 2 ? tt1 : tt2));
            *(LAS bf16*)(lds + IM_KB + img256(16 * (ap * (ap + 1) / 2 + sa) + r, chk) + cb2) = f2bf1(ik * m); }
    }
    MIX_BAR();
    bf16x8 qa4[4];
#pragma unroll
    for (int ks = 0; ks < 4; ++ks) qa4[ks] = *(const LAS bf16x8*)(lds + IM_QA + img256(16 * ia + fr, 4 * ks + g));
#pragma unroll
    for (int jj = 0; jj < 2; ++jj) { const int jb = cc0 + jj; v2u pw = (v2u){0u, 0u};
        if (jb <= ia) {
            f32x4 sc = (f32x4){0.f, 0.f, 0.f, 0.f};
            const unsigned kbrow = 16u * (ia * (ia + 1) / 2 + jb);
#pragma unroll
            for (int ks = 0; ks < 4; ++ks) { const bf16x8 kf = *(const LAS bf16x8*)(lds + IM_KB + img256(kbrow + fr, 4 * ks + g)); sc = __builtin_amdgcn_mfma_f32_16x16x32_bf16(kf, qa4[ks], sc, 0, 0, 0); }
            if (jb == ia) {
#pragma unroll
                for (int r = 0; r < 4; ++r) sc[r] = (4 * g + r <= fr) ? sc[r] : 0.f; }
            pw.x = pk2(sc[0], sc[1]); pw.y = pk2(sc[2], sc[3]);
        }
        *(LAS v2u*)(lds + IM_P + imgP(16 * ia + fr, 2 * jb + (g >> 1)) + 8 * (g & 1)) = pw;
    }
    MIX_BAR();
    unsigned char* rec = F.ws + WS_HP + ((size_t)(b * 4 + h) * 32 + n) * HPU;
#pragma unroll
    for (int j = 0; j < 5; ++j) { const int p = tid + 512 * j; *(v4u*)(rec + (size_t)p * 16) = *(const LAS v4u*)(lds + IM_HCOPY(p)); }
    if (tid < 32) *(f32x4*)(rec + 40960 + tid * 16) = *(const LAS f32x4*)(lastv + 4 * tid);
    MIX_BAR();
}

__device__ __forceinline__ void phase_ssd_dt(Frame& F, const Args& A, int l) {
    const float* DT = (const float*)(F.ws + WS_DT); f32x4* SD = (f32x4*)(F.ws + WS_SD);
    const int gw = F.bid * NWAVES + F.wave, NGW = F.G * NWAVES, lane = F.lane;
    for (int it = gw; it < 8 * 16 * (SEQ / 64); it += NGW) { const int n = it & 31, h = (it >> 5) & 15, b = it >> 9;
        const float dtb = A.in[I_DTB][l * 16 + h], Aneg = -__expf(A.in[I_ALOG][l * 16 + h]);
        const float xdt = DT[((size_t)b * SEQ + n * 64 + lane) * 16 + h] + dtb;
        const float dt = xdt > 20.f ? xdt : log1pf(__expf(xdt));
        float cum = dt * Aneg;
#pragma unroll
        for (int o = 1; o < 64; o <<= 1) { const float tmp = __shfl_up(cum, o); if (lane >= o) cum += tmp; }
        const float wl = __expf(__shfl(cum, 63) - cum);
        SD[((size_t)(b * 16 + h)) * SEQ + n * 64 + lane] = (f32x4){dt, cum, wl, __expf(cum)}; }
}
template <int TYPE>
__device__ __forceinline__ void mix_stream(Frame& F, const Args& A, int l, int b, int h, int half) {
    LAS unsigned char* lds = F.lds;
    const bf16* P = (const bf16*)(F.ws + WS_P); bf16* MO = (bf16*)(F.ws + WS_U);
    LAS float* cumv = (LAS float*)(lds + SM_CUM); LAS float* totv = (LAS float*)(lds + SM_TOT); LAS float* lastv = (LAS float*)(lds + SM_LAST);
    const int tid = F.tid, w = F.wave, lane = F.lane;
    const int ia = w >> 1, cc0 = (w & 1) * 2;
    const int ocol = TYPE == MX_RET ? h * 128 + half * 64 : (TYPE == MX_SSD ? 512 + h * 64 : 1536 + h * 128 + half * 64);
    f32x4 S[4];
#pragma unroll
    for (int c = 0; c < 4; ++c) S[c] = (f32x4){0.f, 0.f, 0.f, 0.f};
    for (int i = tid; i < 1024; i += NWAVES * 64) ((LAS v4u*)(lds + IM_ST))[i] = (v4u){0u, 0u, 0u, 0u};
    const int pt = tid >> 3, pib = tid & 7;
    float vs_scale = 1.f;
    float dtb = 0.f, Aneg = 0.f, dsk = 0.f;
    if constexpr (TYPE == MX_RET) {
        const float lg2 = log2f(1.f - exp2f(-5.f - (float)h));
        vs_scale = exp2f((float)(63 - pt) * lg2);
        if (tid < 64) cumv[tid] = (float)(tid + 1) * lg2 * 0.6931471805599453f;
    }
    if constexpr (TYPE == MX_SSD) {
        dtb = A.in[I_DTB][l * 16 + h]; Aneg = -__expf(A.in[I_ALOG][l * 16 + h]); dsk = A.in[I_SSDD][l * 16 + h];
    }
    const float* cosT = (const float*)(F.ws + WS_ROT); const float* sinT = (const float*)(F.ws + WS_ROT + SZ_ROT);
    v4u rq0, rq1, rk0, rk1, rv; f32x4 rc0, rc1, rs0, rs1;
    f32x4 rsd = (f32x4){0.f, 0.f, 0.f, 0.f};
    v4u hp[5]; f32x4 hlv = (f32x4){0.f, 0.f, 0.f, 0.f};
#define MIX_LOAD(nn) do { const int t0n = (nn) * 64; const size_t row0n = (size_t)b * SEQ + t0n; \
        if constexpr (TYPE == MX_RET) { const size_t pr_ = row0n + pt; \
            rq0 = *(const v4u*)(P + PB(pr_, C_RQ + h * 128 + 8 * pib)); rq1 = *(const v4u*)(P + PB(pr_, C_RQ + h * 128 + 64 + 8 * pib)); \
            rk0 = *(const v4u*)(P + PB(pr_, C_RK + h * 128 + 8 * pib)); rk1 = *(const v4u*)(P + PB(pr_, C_RK + h * 128 + 64 + 8 * pib)); \
            rv = *(const v4u*)(P + PB(pr_, C_RV + h * 128 + half * 64 + 8 * pib)); \
            const f32x4* cp = (const f32x4*)(cosT + (size_t)(t0n + pt) * 64 + 8 * pib); const f32x4* sp = (const f32x4*)(sinT + (size_t)(t0n + pt) * 64 + 8 * pib); \
            rc0 = cp[0]; rc1 = cp[1]; rs0 = sp[0]; rs1 = sp[1]; } \
        if constexpr (TYPE == MX_SSD) { rsd = ((const f32x4*)(F.ws + WS_SD))[(size_t)(b * 16 + h) * SEQ + t0n + lane]; \
            const bf16* xc = (const bf16*)(F.ws + WS_XC) + (row0n + pt) * CONVD; const int grp_ = h >> 3; \
            rq0 = *(const v4u*)(xc + 1280 + grp_ * 128 + 8 * pib); rq1 = *(const v4u*)(xc + 1280 + grp_ * 128 + 64 + 8 * pib); \
            rk0 = *(const v4u*)(xc + 1024 + grp_ * 128 + 8 * pib); rk1 = *(const v4u*)(xc + 1024 + grp_ * 128 + 64 + 8 * pib); \
            rv = *(const v4u*)(xc + h * 64 + 8 * pib); } \
        if constexpr (TYPE == MX_HGRN) { const unsigned char* rec = F.ws + WS_HP + ((size_t)(b * 4 + h) * 32 + (nn)) * HPU; \
            _Pragma("unroll") for (int j = 0; j < 5; ++j) hp[j] = *(const v4u*)(rec + (size_t)(tid + 512 * j) * 16); \
            if (tid < 32) hlv = *(const f32x4*)(rec + 40960 + tid * 16); \
            rv = *(const v4u*)(P + PB(row0n + pt, C_HI + h * 128 + half * 64 + 8 * pib)); } \
    } while (0)
    MIX_LOAD(0);
    MIX_BAR();

    for (int n = 0; n < SEQ / 64; ++n) {
        const int t0 = n * 64; const size_t row0 = (size_t)b * SEQ + t0;
        int lz = lane; asm volatile("" : "+v"(lz));
        const int fr = lz & 15, g = lz >> 4, q4 = fr >> 2, p4 = fr & 3;
        bf16 zr[2][4];
        if constexpr (TYPE == MX_SSD) {
#pragma unroll
            for (int cc = 0; cc < 2; ++cc)
#pragma unroll
                for (int r = 0; r < 4; ++r) zr[cc][r] = P[PB(row0 + 16 * ia + 4 * g + r, C_SZ + h * 64 + 16 * (cc0 + cc) + fr)];
        }
        if constexpr (TYPE == MX_RET) {
            float ql[8], qh[8], kl[8], kh[8], vv[8], cs[8], sn[8], o0[8], o1[8];
            unpack8(rq0, ql); unpack8(rq1, qh); unpack8(rk0, kl); unpack8(rk1, kh); unpack8(rv, vv);
#pragma unroll
            for (int e = 0; e < 4; ++e) { cs[e] = rc0[e]; cs[4 + e] = rc1[e]; sn[e] = rs0[e]; sn[4 + e] = rs1[e]; }
#pragma unroll
            for (int e = 0; e < 8; ++e) { o0[e] = ql[e] * cs[e] - qh[e] * sn[e]; o1[e] = ql[e] * sn[e] + qh[e] * cs[e]; }
            *(LAS v4u*)(lds + IM_QA + img256(pt, pib)) = pack8(o0); *(LAS v4u*)(lds + IM_QA + img256(pt, 8 + pib)) = pack8(o1);
#pragma unroll
            for (int e = 0; e < 8; ++e) { o0[e] = (kl[e] * cs[e] - kh[e] * sn[e]) * 0.08838834764831845f; o1[e] = (kl[e] * sn[e] + kh[e] * cs[e]) * 0.08838834764831845f; }
            *(LAS v4u*)(lds + IM_KB + img256(pt, pib)) = pack8(o0); *(LAS v4u*)(lds + IM_KB + img256(pt, 8 + pib)) = pack8(o1);
            *(LAS v4u*)(lds + IM_V + imgV(pt, pib)) = pack8(vv);
#pragma unroll
            for (int e = 0; e < 8; ++e) vv[e] *= vs_scale;
            *(LAS v4u*)(lds + IM_VS + imgV(pt, pib)) = pack8(vv);
        }
        if constexpr (TYPE == MX_SSD) {
            if (w == 0) { cumv[lane] = rsd[1]; cumv[64 + lane] = rsd[3]; }
            const float sdt = __shfl(rsd[0], pt), swl = __shfl(rsd[2], pt);
            float kl[8], kh[8], vv[8];
            unpack8(rk0, kl); unpack8(rk1, kh); unpack8(rv, vv);
            *(LAS v4u*)(lds + IM_QA + img256(pt, pib)) = rq0; *(LAS v4u*)(lds + IM_QA + img256(pt, 8 + pib)) = rq1;
#pragma unroll
            for (int e = 0; e < 8; ++e) { kl[e] *= sdt; kh[e] *= sdt; }
            *(LAS v4u*)(lds + IM_KB + img256(pt, pib)) = pack8(kl); *(LAS v4u*)(lds + IM_KB + img256(pt, 8 + pib)) = pack8(kh);
            *(LAS v4u*)(lds + IM_V + imgV(pt, pib)) = rv;
#pragma unroll
            for (int e = 0; e < 8; ++e) vv[e] *= swl;
            *(LAS v4u*)(lds + IM_VS + imgV(pt, pib)) = pack8(vv);
        }
        if constexpr (TYPE == MX_HGRN) {
#pragma unroll
            for (int j = 0; j < 5; ++j) *(LAS v4u*)(lds + IM_HCOPY(tid + 512 * j)) = hp[j];
            *(LAS v4u*)(lds + IM_V + imgV(pt, pib)) = rv;
            if (tid < 32) *(LAS f32x4*)(lastv + 4 * tid) = hlv;
        }
        { const int nn = n + 1 < SEQ / 64 ? n + 1 : n; MIX_LOAD(nn); }
        MIX_BAR();
        bf16x8 qa[4];
#pragma unroll
        for (int ks = 0; ks < 4; ++ks) qa[ks] = *(const LAS bf16x8*)(lds + IM_QA + img256(16 * ia + fr, 4 * ks + g));
#pragma unroll
        for (int jj = 0; jj < 2; ++jj) if (TYPE != MX_HGRN) { const int jb = cc0 + jj; v2u pw = (v2u){0u, 0u};
            if (jb <= ia) {
                f32x4 sc = (f32x4){0.f, 0.f, 0.f, 0.f};
                const unsigned kbrow = TYPE == MX_HGRN ? 16u * (ia * (ia + 1) / 2 + jb) : 16u * jb;
#pragma unroll
                for (int ks = 0; ks < 4; ++ks) { const bf16x8 kf = *(const LAS bf16x8*)(lds + IM_KB + img256(kbrow + fr, 4 * ks + g)); sc = __builtin_amdgcn_mfma_f32_16x16x32_bf16(kf, qa[ks], sc, 0, 0, 0); }
                if constexpr (TYPE != MX_HGRN) { const float ci = cumv[16 * ia + fr]; const f32x4 cj = *(const LAS f32x4*)(cumv + 16 * jb + 4 * g);
#pragma unroll
                    for (int r = 0; r < 4; ++r) sc[r] *= __expf(fminf(ci - cj[r], 0.f)); }
                if (jb == ia) {
#pragma unroll
                    for (int r = 0; r < 4; ++r) sc[r] = (4 * g + r <= fr) ? sc[r] : 0.f; }
                pw.x = pk2(sc[0], sc[1]); pw.y = pk2(sc[2], sc[3]);
            }
            *(LAS v2u*)(lds + IM_P + imgP(16 * ia + fr, 2 * jb + (g >> 1)) + 8 * (g & 1)) = pw;
        }
        f32x4 qs[2];
        {
            bf16x8 qb[4];
            if constexpr (TYPE == MX_HGRN) {
#pragma unroll
                for (int ks = 0; ks < 4; ++ks) qb[ks] = *(const LAS bf16x8*)(lds + IM_QB + img256(16 * ia + fr, 4 * ks + g));
            } else {
#pragma unroll
                for (int ks = 0; ks < 4; ++ks) qb[ks] = qa[ks];
            }
#pragma unroll
            for (int cc = 0; cc < 2; ++cc) { qs[cc] = (f32x4){0.f, 0.f, 0.f, 0.f};
#pragma unroll
                for (int ks = 0; ks < 4; ++ks) { const bf16x8 sf = *(const LAS bf16x8*)(lds + IM_ST + img256(16 * (cc0 + cc) + fr, 4 * ks + g)); qs[cc] = __builtin_amdgcn_mfma_f32_16x16x32_bf16(qb[ks], sf, qs[cc], 0, 0, 0); } }
        }
        MIX_BAR();
        {
            const unsigned tra0 = (unsigned)(8 * g + q4), trc = (unsigned)(p4 >> 1), trb = 8u * (unsigned)(p4 & 1);
#pragma unroll
            for (int cc = 0; cc < 2; ++cc) { const int c = cc0 + cc; f32x4 pv = (f32x4){0.f, 0.f, 0.f, 0.f};
#pragma unroll
                for (int ks = 0; ks < 2; ++ks) if (ks == 0 || ia >= 2) {
                    const bf16x8 pf = *(const LAS bf16x8*)(lds + IM_P + imgP(16 * ia + fr, 4 * ks + g));
                    const bf16x8 vf = tr_pair(lds + IM_V, imgV(32 * ks + tra0, 2 * c + trc) + trb, imgV(32 * ks + tra0 + 4, 2 * c + trc) + trb);
                    pv = __builtin_amdgcn_mfma_f32_16x16x32_bf16(pf, vf, pv, 0, 0, 0); }
#pragma unroll
                for (int r = 0; r < 4; ++r) { const int i = 16 * ia + 4 * g + r, v = 16 * c + fr; float o;
                    if constexpr (TYPE == MX_HGRN) o = pv[r] + qs[cc][r]; else if constexpr (TYPE == MX_SSD) o = pv[r] + cumv[64 + i] * qs[cc][r]; else o = pv[r] + __expf(cumv[i]) * qs[cc][r];
                    if constexpr (TYPE == MX_SSD) { const float xv = bf2f(*(const LAS bf16*)(lds + IM_V + imgV(i, v >> 3) + (v & 7) * 2)); o = (o + dsk * xv) * siluf(bf2f(zr[cc][r])); }
                    MO[(row0 + i) * DM + ocol + v] = f2bf1(o); }
            }
            if constexpr (TYPE == MX_HGRN) { const f32x4 d = *(const LAS f32x4*)(lastv + 16 * w + 4 * g);
#pragma unroll
                for (int c = 0; c < 4; ++c) S[c] = S[c] * d; }
            else { const float d = TYPE == MX_SSD ? cumv[64 + 63] : __expf(cumv[63]);
#pragma unroll
                for (int c = 0; c < 4; ++c) S[c] = S[c] * d; }
            constexpr int IMK = TYPE == MX_HGRN ? IM_KS : IM_KB, IMV2 = TYPE == MX_HGRN ? IM_V : IM_VS;
#pragma unroll
            for (int ks = 0; ks < 2; ++ks) {
                const bf16x8 af = tr_pair(lds + IMK, img256(32 * ks + tra0, 2 * w + trc) + trb, img256(32 * ks + tra0 + 4, 2 * w + trc) + trb);
#pragma unroll
                for (int c = 0; c < 4; ++c) { const bf16x8 bv = tr_pair(lds + IMV2, imgV(32 * ks + tra0, 2 * c + trc) + trb, imgV(32 * ks + tra0 + 4, 2 * c + trc) + trb);
                    S[c] = __builtin_amdgcn_mfma_f32_16x16x32_bf16(af, bv, S[c], 0, 0, 0); } }
        }
        MIX_BAR();
#pragma unroll
        for (int c = 0; c < 4; ++c) { v2u sw; sw.x = pk2(S[c][0], S[c][1]); sw.y = pk2(S[c][2], S[c][3]);
            *(LAS v2u*)(lds + IM_ST + img256(16 * c + fr, 2 * w + (g >> 1)) + 8 * (g & 1)) = sw; }
    }
    VM_WAIT(); MIX_BAR();
#undef MIX_LOAD
}

__device__ __forceinline__ void phase_mix(Frame& F, const Args& A, int l) {
    { const int s = F.bid;
        if (s < 64) { { const int x = s & 7, j = s >> 3, pr = (j >> 1) * 8 + x; mix_stream<MX_RET>(F, A, l, pr >> 2, pr & 3, j & 1); }     }
        else if (s < 192) { const int sb = s - 64; { const int x = sb & 7, j = sb >> 3, pg = (j >> 3) * 8 + x; mix_stream<MX_SSD>(F, A, l, pg >> 1, (pg & 1) * 8 + (j & 7), 0); }     }
        else { const int sb = s - 192; { const int x = sb & 7, j = sb >> 3, pr = (j >> 1) * 8 + x; mix_stream<MX_HGRN>(F, A, l, pr >> 2, pr & 3, j & 1); } }
    }
}

__device__ __forceinline__ void phase_ssdnorm(Frame& F, const Args& A, int l) {
    bf16* MO = (bf16*)(F.ws + WS_U); const bf16* P = (const bf16*)(F.ws + WS_P);
    const int gw = F.bid * NWAVES + F.wave, NGW = F.G * NWAVES, lane = F.lane;
    const int kind = lane < 16 ? 0 : (lane < 48 ? 1 : 2);
    float wq[32];
    { const float* wp = kind == 1 ? A.in[I_SSDNW] + l * 1024 + 32 * (lane - 16) : A.in[I_HNW] + l * 512 + 32 * ((lane - 48) & 15);
#pragma unroll
        for (int j = 0; j < 32; ++j) wq[j] = kind != 0 ? wp[j] : 1.f; }
    for (int row = gw; row < NTOK; row += 2 * NGW) {
        v4u xin[2][4], gin[2][4];
#pragma unroll
        for (int q = 0; q < 2; ++q) { const size_t rw = (size_t)row + (size_t)q * NGW;
            const v4u* p = (const v4u*)(MO + rw * DM + 32 * lane);
            const v4u* gp = (const v4u*)(P + PB(rw, kind == 0 ? C_RG + 32 * lane : C_HG + 32 * ((lane - 48) & 15)));
#pragma unroll
            for (int c = 0; c < 4; ++c) { xin[q][c] = p[c]; gin[q][c] = kind != 1 ? gp[c] : (v4u){0u, 0u, 0u, 0u}; } }
#pragma unroll
        for (int q = 0; q < 2; ++q) { const size_t rw = (size_t)row + (size_t)q * NGW;
            float f[32];
#pragma unroll
            for (int c = 0; c < 4; ++c) { float t8[8]; unpack8(xin[q][c], t8);
#pragma unroll
                for (int j = 0; j < 8; ++j) f[8 * c + j] = t8[j]; }
            float ss = 0.f;
#pragma unroll
            for (int j = 0; j < 32; ++j) ss += f[j] * f[j];
            ss += __shfl_xor(ss, 1); ss += __shfl_xor(ss, 2);
            float s16 = ss; s16 += __shfl_xor(s16, 4); s16 += __shfl_xor(s16, 8);
            const float rstd = 1.f / sqrtf((kind == 1 ? s16 * (1.f / 512.f) : ss * (1.f / 128.f)) + EPS);
            v4u* po = (v4u*)(MO + rw * DM + 32 * lane);
#pragma unroll
            for (int c = 0; c < 4; ++c) { float o[8], gg[8]; unpack8(gin[q][c], gg);
#pragma unroll
                for (int j = 0; j < 8; ++j) { float v = f[8 * c + j] * rstd * wq[8 * c + j]; if (kind != 1) v *= siluf(gg[j]); o[j] = v; }
                po[c] = pack8(o); }
        }
    }
}

__device__ __forceinline__ void phase_final(Frame& F, const Args& A) {
    const bf16* Y = (const bf16*)(F.ws + WS_Y); const int* slot = (const int*)(F.ws + WS_SLOT);
    build_tables(F, NLAYER - 1);
    const int gw = F.bid * NWAVES + F.wave, NGW = F.G * NWAVES;
    f32x4 wv[8]; load_normw(A.in[I_FINW], wv, F.lane);
    for (int row = gw; row < NTOK; row += 2 * NGW) {
        const float* src[2]; float* hd[2] = {nullptr, nullptr}; const bf16* ya[2]; const bf16* yb[2]; bf16* ud[2] = {nullptr, nullptr}; float* fd[2];
#pragma unroll
        for (int q = 0; q < 2; ++q) { const int rw = row + q * NGW; const int s0 = slot[rw * 2], s1 = slot[rw * 2 + 1];
            ya[q] = Y + ((size_t)F.tab[T_EBASE + (s0 >> 16)] * 256 + (s0 & 0xffff)) * (MOE_FP8 ? DM / 2 : DM); yb[q] = Y + ((size_t)F.tab[T_EBASE + (s1 >> 16)] * 256 + (s1 & 0xffff)) * (MOE_FP8 ? DM / 2 : DM);
            src[q] = H_BF16 ? (const float*)((const bf16*)(F.ws + WS_H) + (size_t)rw * DM) : F.out + (size_t)rw * DM; fd[q] = F.out + (size_t)rw * DM; }
        norm_rows<2, 2, false, H_BF16>(src, hd, ya, yb, wv, ud, fd, F.lane); }
}

constexpr int NPH = 8, GP_TOTAL = 2 + NLAYER * NPH;
__global__ void __launch_bounds__(NWAVES * 64, 2) mk_fwd(Args args) {
    extern __shared__ __attribute__((aligned(16))) unsigned char lds[];
    Frame F;
    F.lds = (LAS unsigned char*)lds;
    F.MISC = (volatile LAS unsigned*)(F.lds + MISC_OFF);
    F.tab = (LAS int*)(F.lds + TAB_OFF);
    F.tid = threadIdx.x; F.lane = F.tid & 63; F.wave = __builtin_amdgcn_readfirstlane(F.tid >> 6);
    F.G = gridDim.x; F.bid = blockIdx.x;
    F.out = args.out; F.ws = args.ws; F.ctl = (unsigned*)(args.ws + WS_CTL);
    for (int u = F.tid; u < (LDS_BYTES - LDSCTL_OFF) / 4; u += NWAVES * 64) ((LAS unsigned*)(F.lds + LDSCTL_OFF))[u] = 0u;
    __syncthreads();
    const int lo = args.gp_lo, hi = args.gp_hi;
    XcdBarrier bar; bar.bar = F.ctl + CW_BAR; bar.x = 0; bar.st = nullptr;
    if (hi - lo > 1) bar = xcd_barrier_post(F.ctl + CW_BAR, F.MISC + 8);
#define IN(k) (lo <= (k) && (k) < hi)
#define SEAM(k) do { if ((k) + 1 < hi) xcd_barrier(bar); } while (0)

    if (IN(0)) { phase_prologue(F, args); SEAM(0); }
#define LAYER_BODY(l, pb) \
        if (IN(pb + 0)) { phase_norm1(F, args, l); SEAM(pb + 0); } \
        if (IN(pb + 1)) { \
            pg8::Gemm g{(const bf16*)(F.ws + WS_U), (const bf16*)(F.ws + WS_WIN + l * SZ_WIN), NTOK, NP, DM, 0u}; pg8::StaticOrder S; \
            pg8::EpiBf16Blk E{(bf16*)(F.ws + WS_P), NTOK}; \
            if (l == 0) { if (F.bid < G1_WGS) { S.init(NTOK, NP, G1_WGS, F.bid); pg8::gemm_phase<pg8::EpiBf16Blk, pg8::StaticOrder, true>(F.lds, g, S, E); } \
                          else convert_items(F, args, CONV_SPLIT, CT_LO, (F.bid - G1_WGS) * NWAVES + F.wave, (F.G - G1_WGS) * NWAVES); } \
            else { S.init(NTOK, NP, F.G, F.bid); pg8::gemm_phase<pg8::EpiBf16Blk, pg8::StaticOrder, true>(F.lds, g, S, E); \
                   if (F.bid >= 128) convert_items(F, args, CT_LO, NLAYER * TI_LAYER, (F.bid - 128) * NWAVES + F.wave, 128 * NWAVES); } \
            SEAM(pb + 1); \
        } \
        if (IN(pb + 2)) { phase_ssd_dt(F, args, l); phase_conv(F, args, l); for (int u = F.bid; u < 1024; u += F.G) hgrn_prep_unit(F, args, l, u >> 7, (u >> 5) & 3, u & 31); xcd_barrier(bar); phase_mix(F, args, l); SEAM(pb + 2); } \
        if (IN(pb + 3)) { phase_ssdnorm(F, args, l); SEAM(pb + 3); } \
        if (IN(pb + 4)) { \
            pg8::Gemm g{(const bf16*)(F.ws + WS_U), (const bf16*)(F.ws + WS_WOUT + l * SZ_WOUT), NTOK, DM, DM, 0u}; pg8::StaticOrder S; S.init(NTOK, DM, F.G, F.bid); \
            if (H_BF16) { if (l == 0) { pg8::EpiResH<true> E{args.in[I_X], (bf16*)(F.ws + WS_H), DM}; pg8::gemm_phase<pg8::EpiResH<true>, pg8::StaticOrder, false>(F.lds, g, S, E); } \
                          else { pg8::EpiResH<false> E{(const void*)(F.ws + WS_H), (bf16*)(F.ws + WS_H), DM}; pg8::gemm_phase<pg8::EpiResH<false>, pg8::StaticOrder, false>(F.lds, g, S, E); } } \
            else { pg8::EpiResF32 E{l == 0 ? args.in[I_X] : F.out, F.out, DM}; pg8::gemm_phase<pg8::EpiResF32, pg8::StaticOrder, false>(F.lds, g, S, E); } \
            SEAM(pb + 4); \
        } \
        if (IN(pb + 5)) { phase_norm2(F, args, l); SEAM(pb + 5); } \
        if (IN(pb + 6)) { \
            build_tables(F, l); \
            const int ntiles = (int)F.MISC[16]; \
            const int* tokl = (const int*)(F.ws + WS_TOK); \
            for (int i = 0; i < 4; ++i) { const int L = i * F.G + F.bid; if (L < ntiles * 4) { const int v = F.tab[T_TMAP + L / 4], e = v >> 8, lt = v & 255, cnt = F.tab[T_ECNT + e]; \
                for (int r = F.tid; r < 256; r += NWAVES * 64) { const int lr = lt * 256 + r; F.tab[T_GTAB + i * 256 + r] = tokl[(size_t)e * NTOK + (lr < cnt ? lr : 0)]; } } } \
            __syncthreads(); \
            pg8::MoeOrder<true> S{F.tab + T_TMAP, F.tab + T_GTAB, ntiles, 4, F.G, F.bid, SZ_WGU1}; \
            if (MOE_FP8) { pg8::Gemm g{(const bf16*)(F.ws + WS_U8), (const bf16*)(F.ws + WS_WGU + (size_t)l * NEXP * SZ_WGU1), PADROWS, 1024, DM / 2, 0x79797979u}; \
                pg8::EpiSwiGlu8 E{F.ws + WS_HID}; pg8::gemm_phase<pg8::EpiSwiGlu8, pg8::MoeOrder<true>, true, true>(F.lds, g, S, E); } \
            else { pg8::Gemm g{(const bf16*)(F.ws + WS_U), (const bf16*)(F.ws + WS_WGU + (size_t)l * NEXP * SZ_WGU1), PADROWS, 1024, DM, 0u}; \
                pg8::EpiSwiGlu E{(bf16*)(F.ws + WS_HID)}; pg8::gemm_phase<pg8::EpiSwiGlu, pg8::MoeOrder<true>, true>(F.lds, g, S, E); } \
            SEAM(pb + 6); \
        } \
        if (IN(pb + 7)) { \
            build_tables(F, l); \
            const int ntiles = (int)F.MISC[16]; \
            pg8::MoeOrder<false> S{F.tab + T_TMAP, F.tab + T_GTAB, ntiles, 8, F.G, F.bid, SZ_WD1}; \
            pg8::EpiScaleBf16 E{(bf16*)(F.ws + WS_Y), DM, (const float*)(F.ws + WS_WT), F.tab + T_ECNT}; \
            if (MOE_FP8) { pg8::Gemm g{(const bf16*)(F.ws + WS_HID), (const bf16*)(F.ws + WS_WD + (size_t)l * NEXP * SZ_WD1), PADROWS, DM, DEXP / 2, 0x7a7a7a7au}; \
                pg8::EpiScaleF8 E8{F.ws + WS_Y, DM, (const float*)(F.ws + WS_WT), F.tab + T_ECNT}; \
                pg8::gemm_phase<pg8::EpiScaleF8, pg8::MoeOrder<false>, true, true>(F.lds, g, S, E8); } \
            else { pg8::Gemm g{(const bf16*)(F.ws + WS_HID), (const bf16*)(F.ws + WS_WD + (size_t)l * NEXP * SZ_WD1), PADROWS, DM, DEXP, 0u}; \
                pg8::gemm_phase<pg8::EpiScaleBf16, pg8::MoeOrder<false>, true>(F.lds, g, S, E); } \
            SEAM(pb + 7); \
        }
    { constexpr int l = 0, pb = 1; LAYER_BODY(l, pb) }
    { constexpr int l = 1, pb = 1 + NPH; LAYER_BODY(l, pb) }
#undef LAYER_BODY
    if (IN(GP_TOTAL - 1)) phase_final(F, args);
#undef IN
#undef SEAM
}

extern "C" void kernel_launch(void* const* d_in, const int* in_sizes, int n_in, void* d_out, int out_size, void* d_ws, size_t ws_size, hipStream_t stream) {
    static int grid = 0;
    if (grid == 0) {
        if (n_in != 21 || out_size != NTOK * DM || ws_size < WS_END) { fprintf(stderr, "kernel_launch: unexpected shapes (n_in %d, out %d, ws %zu, need %zu)\n", n_in, out_size, ws_size, (size_t)WS_END); grid = -1; return; }
        int dev = 0, cus = 0, per_cu = 0;
        if (hipGetDevice(&dev) != hipSuccess || hipDeviceGetAttribute(&cus, hipDeviceAttributeMultiprocessorCount, dev) != hipSuccess) { grid = -1; return; }
        if (hipFuncSetAttribute((const void*)mk_fwd, hipFuncAttributeMaxDynamicSharedMemorySize, LDS_BYTES) != hipSuccess) { fprintf(stderr, "kernel_launch: hipFuncSetAttribute failed\n"); grid = -1; return; }
        if (hipOccupancyMaxActiveBlocksPerMultiprocessor(&per_cu, (const void*)mk_fwd, NWAVES * 64, LDS_BYTES) != hipSuccess || per_cu < 1) fprintf(stderr, "kernel_launch: occupancy query reports %d\n", per_cu);
        (void)hipGetLastError();
        grid = cus;
        if (grid != 256) { fprintf(stderr, "kernel_launch: built for a 256-CU device (got %d)\n", cus); grid = -1; return; }
    }
    if (grid < 0) return;
    if (hipMemsetAsync((char*)d_ws + WS_CTL, 0, CTL_ZERO_BYTES, stream) != hipSuccess) return;
    Args a{};
    for (int i = 0; i < 21; ++i) a.in[i] = (const float*)d_in[i];
    a.out = (float*)d_out; a.ws = (unsigned char*)d_ws;
#if MK_LAUNCH_PER_PHASE
    for (int p = 0; p < GP_TOTAL; ++p) { a.gp_lo = p; a.gp_hi = p + 1; hipLaunchKernelGGL(mk_fwd, dim3(grid), dim3(NWAVES * 64), LDS_BYTES, stream, a); }
#else
    a.gp_lo = 0; a.gp_hi = GP_TOTAL;
    hipLaunchKernelGGL(mk_fwd, dim3(grid), dim3(NWAVES * 64), LDS_BYTES, stream, a);
#endif
    const hipError_t le = hipPeekAtLastError();
    if (le != hipSuccess) fprintf(stderr, "kernel_launch: launch failed: %s\n", hipGetErrorName(le));
}
```

```cpp
#include <hip/hip_runtime.h>
#include <cstdio>
#include <cstdint>

#ifndef MOE_FP8
#define MOE_FP8 1
#endif
#ifndef H_BF16
#define H_BF16 1
#endif
#ifndef MK_LAUNCH_PER_PHASE
#define MK_LAUNCH_PER_PHASE 0
#endif

#define LAS __attribute__((address_space(3)))
#define GAS __attribute__((address_space(1)))
typedef unsigned short bf16;
typedef unsigned v4u __attribute__((ext_vector_type(4)));
typedef unsigned v2u __attribute__((ext_vector_type(2)));
typedef float f32x4 __attribute__((ext_vector_type(4)));
typedef float f32x2 __attribute__((ext_vector_type(2)));
typedef short bf16x8 __attribute__((ext_vector_type(8)));
typedef GAS unsigned gu32;
#define RLX_AGENT __ATOMIC_RELAXED, __HIP_MEMORY_SCOPE_AGENT
#define LDS_WAIT() asm volatile("s_waitcnt lgkmcnt(0)" ::: "memory")
#define VM_WAIT() asm volatile("s_waitcnt vmcnt(0)" ::: "memory")

constexpr int DM = 2048, NTOK = 16384, SEQ = 2048, NLAYER = 2;
constexpr int IN_DIM = 6672, NP = 6656;
constexpr int C_RQ = 0, C_RK = 512, C_RV = 1024, C_RG = 1536, C_SZ = 2048, C_SX = 3072, C_SB = 4096, C_SC = 4352, C_HQ = 4608, C_HF = 5120, C_HI = 5632, C_HG = 6144;
constexpr int DT_COL0 = 4608;
constexpr int NEXP = 32, DEXP = 512, CONVD = 1536;
constexpr int MAXTILES = 161, PADROWS = MAXTILES * 256;
constexpr float EPS = 1e-6f;

__host__ __device__ __forceinline__ size_t PB(size_t row, int col) { return ((size_t)(col >> 7) * NTOK + row) * 128 + (col & 127); }
__device__ __forceinline__ float bf2f(bf16 x) { return __uint_as_float(((unsigned)x) << 16); }
__device__ __forceinline__ unsigned f2bf(float f) { unsigned u = __float_as_uint(f); return (u + 0x7fffu + ((u >> 16) & 1u)) >> 16; }
typedef __bf16 bf16x2v __attribute__((ext_vector_type(2)));
__device__ __forceinline__ unsigned pk2(float lo, float hi) { const f32x2 v = {lo, hi}; return __builtin_bit_cast(unsigned, __builtin_convertvector(v, bf16x2v)); }
__device__ __forceinline__ bf16 f2bf1(float f) { return (bf16)pk2(f, f); }
__device__ __forceinline__ float siluf(float x) { return x * __builtin_amdgcn_rcpf(1.f + __expf(-x)); }
__device__ __forceinline__ float sigmf(float x) { return __builtin_amdgcn_rcpf(1.f + __expf(-x)); }
__device__ __forceinline__ float wave_sum(float v) {
#pragma unroll
    for (int o = 1; o < 64; o <<= 1) v += __shfl_xor(v, o);
    return v;
}

#define cvt2_fp8(a, b, old, hi) __builtin_amdgcn_cvt_pk_fp8_f32(__builtin_amdgcn_fmed3f((a), -448.f, 448.f), __builtin_amdgcn_fmed3f((b), -448.f, 448.f), (old), (hi))
namespace pg8 {
constexpr int BM = 256, BK = 64, HALF = 128, HTB = HALF * BK * 2, STAGE_BYTES = 8 * HTB, NXCD = 8, WGM = 8;
__host__ __device__ __forceinline__ int lds_byte(int r, int c) { const int st = (r >> 4) * 2 + (c >> 5), rr = r & 15, cc = c & 31, ob = rr * 64 + cc * 2; return st * 1024 + (ob ^ (((ob >> 9) & 1) << 5)); }
__host__ __device__ __forceinline__ void stage_rc(int b, int& R, int& C) { const int st = b / 1024, sb = b % 1024, swz = sb ^ (((sb >> 9) & 1) << 5); R = (st >> 1) * 16 + swz / 64; C = (st & 1) * 32 + (swz % 64) / 2; }
__host__ __device__ __forceinline__ int perm32(int rho) { const int n = rho >> 4, i = rho & 15; return 8 * (i >> 2) + 4 * n + (i & 3); }

struct Unit { int pm, pn, e, lt; };
struct Gemm { const bf16* A; const bf16* Bt; int M, N, K; unsigned wscale; };

struct StaticOrder {
    static constexpr bool GATHER = false;
    int nM, nN, nwg, G, c;
    __device__ void init(int M, int N, int G_, int c_) { nM = M / BM; nN = N / BM; nwg = nM * nN; G = G_; c = c_; }
    __device__ bool next(int i, Unit& u) const {
        const long L = (long)i * G + c; if (L >= nwg) return false;
        int wgid = (int)L; { const int q = nwg / NXCD, r = nwg % NXCD, xcd = wgid % NXCD, off = wgid / NXCD; wgid = (xcd < r ? xcd * (q + 1) : r * (q + 1) + (xcd - r) * q) + off; }
        const int nig = WGM * nN, gid = wgid / nig, fm = gid * WGM, gsz = (nM - fm) < WGM ? (nM - fm) : WGM;
        u.pm = fm + ((wgid % nig) % gsz); u.pn = (wgid % nig) / gsz; u.e = 0; u.lt = 0; return true;
    }
    __device__ __forceinline__ const char* a_base(const Gemm& g, const Unit& u) const { return (const char*)g.A + (size_t)u.pm * ((size_t)BM * g.K * 2); }
    __device__ __forceinline__ const char* b_base(const Gemm& g, const Unit& u) const { return (const char*)g.Bt + (size_t)u.pn * ((size_t)BM * g.K * 2); }
    __device__ __forceinline__ int gidx(int, int) const { return 0; }
};
template <bool GA> struct MoeOrder {
    static constexpr bool GATHER = GA;
    const LAS int* tmap; const LAS int* gtab; int ntiles, nN, G, c; size_t bstride;
    __device__ bool next(int i, Unit& u) const {
        const int L = i * G + c; if (L >= ntiles * nN) return false;
        const int mt = L / nN; const int v = tmap[mt]; u.pm = mt; u.pn = L - mt * nN; u.e = v >> 8; u.lt = v & 255; return true;
    }
    __device__ __forceinline__ const char* a_base(const Gemm& g, const Unit& u) const { return GA ? (const char*)g.A : (const char*)g.A + (size_t)u.pm * ((size_t)BM * g.K * 2); }
    __device__ __forceinline__ const char* b_base(const Gemm& g, const Unit& u) const { return (const char*)g.Bt + (size_t)u.e * bstride + (size_t)u.pn * ((size_t)BM * g.K * 2); }
    __device__ __forceinline__ int gidx(int ui, int r) const { return gtab[ui * 256 + r]; }
};

__device__ __forceinline__ unsigned cvt_pk_bf16(float lo, float hi) { return pk2(lo, hi); }

struct EpiBf16 {
    static constexpr bool PERM = true;
    bf16* O; int ldc;
    __device__ __forceinline__ void operator()(const f32x4 (&acc)[2][2][4][2], const Unit& u, int wr, int wc, int fr, int fq) const {
        const int row0 = u.pm * BM + wr * 64 + fr, col0 = u.pn * BM + wc * 32 + 8 * fq;
#pragma unroll
        for (int ai = 0; ai < 2; ++ai)
#pragma unroll
            for (int m = 0; m < 4; ++m) { bf16* rowp = O + (size_t)(row0 + ai * HALF + m * 16) * ldc + col0;
#pragma unroll
                for (int bj = 0; bj < 2; ++bj) { const f32x4 v0 = acc[ai][bj][m][0], v1 = acc[ai][bj][m][1];
                    v4u w; w.x = cvt_pk_bf16(v0[0], v0[1]); w.y = cvt_pk_bf16(v0[2], v0[3]); w.z = cvt_pk_bf16(v1[0], v1[1]); w.w = cvt_pk_bf16(v1[2], v1[3]);
                    *(v4u*)(rowp + bj * HALF) = w; } }
    }
};
struct EpiBf16Blk {
    static constexpr bool PERM = true;
    bf16* O; int M;
    __device__ __forceinline__ void operator()(const f32x4 (&acc)[2][2][4][2], const Unit& u, int wr, int wc, int fr, int fq) const {
        const int row0 = u.pm * BM + wr * 64 + fr, cin = wc * 32 + 8 * fq;
#pragma unroll
        for (int ai = 0; ai < 2; ++ai)
#pragma unroll
            for (int m = 0; m < 4; ++m) {
#pragma unroll
                for (int bj = 0; bj < 2; ++bj) { const f32x4 v0 = acc[ai][bj][m][0], v1 = acc[ai][bj][m][1];
                    v4u w; w.x = cvt_pk_bf16(v0[0], v0[1]); w.y = cvt_pk_bf16(v0[2], v0[3]); w.z = cvt_pk_bf16(v1[0], v1[1]); w.w = cvt_pk_bf16(v1[2], v1[3]);
                    *(v4u*)(O + ((size_t)(2 * u.pn + bj) * M + (row0 + ai * HALF + m * 16)) * 128 + cin) = w; } }
    }
};
struct EpiResF32 {
    static constexpr bool PERM = false;
    const float* res; float* out; int ldc;
    __device__ __forceinline__ void operator()(const f32x4 (&acc)[2][2][4][2], const Unit& u, int wr, int wc, int fr, int fq) const {
        const int row0 = u.pm * BM + wr * 64 + fr, col0 = u.pn * BM + wc * 32 + 4 * fq;
#pragma unroll
        for (int ai = 0; ai < 2; ++ai)
#pragma unroll
            for (int m = 0; m < 4; ++m) { const size_t off = (size_t)(row0 + ai * HALF + m * 16) * ldc + col0;
#pragma unroll
                for (int bj = 0; bj < 2; ++bj)
#pragma unroll
                    for (int n = 0; n < 2; ++n) { const f32x4 r = *(const f32x4*)(res + off + bj * HALF + n * 16); *(f32x4*)(out + off + bj * HALF + n * 16) = r + acc[ai][bj][m][n]; } }
    }
};
template <bool RES_F32> struct EpiResH {
    static constexpr bool PERM = true;
    const void* res; bf16* out; int ldc;
    __device__ __forceinline__ void operator()(const f32x4 (&acc)[2][2][4][2], const Unit& u, int wr, int wc, int fr, int fq) const {
        const int row0 = u.pm * BM + wr * 64 + fr, col0 = u.pn * BM + wc * 32 + 8 * fq;
#pragma unroll
        for (int ai = 0; ai < 2; ++ai)
#pragma unroll
            for (int m = 0; m < 4; ++m) { const size_t off = (size_t)(row0 + ai * HALF + m * 16) * ldc + col0;
#pragma unroll
                for (int bj = 0; bj < 2; ++bj) { f32x4 r0, r1;
                    if constexpr (RES_F32) { const float* rp = (const float*)res + off + bj * HALF; r0 = *(const f32x4*)rp; r1 = *(const f32x4*)(rp + 4); }
                    else { const v4u h_ = *(const v4u*)((const bf16*)res + off + bj * HALF);
                        r0 = (f32x4){__uint_as_float(h_.x << 16), __uint_as_float(h_.x & 0xffff0000u), __uint_as_float(h_.y << 16), __uint_as_float(h_.y & 0xffff0000u)};
                        r1 = (f32x4){__uint_as_float(h_.z << 16), __uint_as_float(h_.z & 0xffff0000u), __uint_as_float(h_.w << 16), __uint_as_float(h_.w & 0xffff0000u)}; }
                    const f32x4 v0 = r0 + acc[ai][bj][m][0], v1 = r1 + acc[ai][bj][m][1];
                    v4u w; w.x = cvt_pk_bf16(v0[0], v0[1]); w.y = cvt_pk_bf16(v0[2], v0[3]); w.z = cvt_pk_bf16(v1[0], v1[1]); w.w = cvt_pk_bf16(v1[2], v1[3]);
                    *(v4u*)(out + off + bj * HALF) = w; } }
    }
};
struct EpiSwiGlu {
    static constexpr bool PERM = true;
    bf16* H;
    __device__ __forceinline__ void operator()(const f32x4 (&acc)[2][2][4][2], const Unit& u, int wr, int wc, int fr, int fq) const {
        const int row0 = u.pm * BM + wr * 64 + fr, col0 = u.pn * 128 + wc * 32 + 8 * fq;
#pragma unroll
        for (int ai = 0; ai < 2; ++ai)
#pragma unroll
            for (int m = 0; m < 4; ++m) { bf16* rowp = H + (size_t)(row0 + ai * HALF + m * 16) * DEXP + col0;
                float o[8];
#pragma unroll
                for (int n = 0; n < 2; ++n)
#pragma unroll
                    for (int j = 0; j < 4; ++j) { const float g = acc[ai][0][m][n][j], up = acc[ai][1][m][n][j]; o[n * 4 + j] = (g * __builtin_amdgcn_rcpf(1.f + __expf(-g))) * up; }
                v4u w; w.x = cvt_pk_bf16(o[0], o[1]); w.y = cvt_pk_bf16(o[2], o[3]); w.z = cvt_pk_bf16(o[4], o[5]); w.w = cvt_pk_bf16(o[6], o[7]);
                *(v4u*)rowp = w; }
    }
};
struct EpiSwiGlu8 {
    static constexpr bool PERM = true;
    unsigned char* H;
    __device__ __forceinline__ void operator()(const f32x4 (&acc)[2][2][4][2], const Unit& u, int wr, int wc, int fr, int fq) const {
        const int row0 = u.pm * BM + wr * 64 + fr, col0 = u.pn * 128 + wc * 32 + 8 * fq;
#pragma unroll
        for (int ai = 0; ai < 2; ++ai)
#pragma unroll
            for (int m = 0; m < 4; ++m) { unsigned char* rowp = H + (size_t)(row0 + ai * HALF + m * 16) * DEXP + col0;
                float o[8];
#pragma unroll
                for (int n = 0; n < 2; ++n)
#pragma unroll
                    for (int j = 0; j < 4; ++j) { const float g = acc[ai][0][m][n][j], up = acc[ai][1][m][n][j]; o[n * 4 + j] = (g * __builtin_amdgcn_rcpf(1.f + __expf(-g))) * up; }
                int w0 = 0, w1 = 0;
                w0 = cvt2_fp8(o[0], o[1], w0, false); w0 = cvt2_fp8(o[2], o[3], w0, true);
                w1 = cvt2_fp8(o[4], o[5], w1, false); w1 = cvt2_fp8(o[6], o[7], w1, true);
                *(v2u*)rowp = (v2u){(unsigned)w0, (unsigned)w1}; }
    }
};
struct EpiScaleBf16 {
    static constexpr bool PERM = true;
    bf16* Y; int ldc; const float* wt; const LAS int* ecnt;
    __device__ __forceinline__ void operator()(const f32x4 (&acc)[2][2][4][2], const Unit& u, int wr, int wc, int fr, int fq) const {
        const int row0 = u.pm * BM + wr * 64 + fr, col0 = u.pn * BM + wc * 32 + 8 * fq;
        const int cnt = ecnt[u.e]; const float* wl = wt + (size_t)u.e * NTOK;
#pragma unroll
        for (int ai = 0; ai < 2; ++ai)
#pragma unroll
            for (int m = 0; m < 4; ++m) { const int lr = u.lt * 256 + wr * 64 + fr + ai * HALF + m * 16; const float s = lr < cnt ? wl[lr] : 0.f;
                bf16* rowp = Y + (size_t)(row0 + ai * HALF + m * 16) * ldc + col0;
#pragma unroll
                for (int bj = 0; bj < 2; ++bj) { const f32x4 v0 = acc[ai][bj][m][0] * s, v1 = acc[ai][bj][m][1] * s;
                    v4u w; w.x = cvt_pk_bf16(v0[0], v0[1]); w.y = cvt_pk_bf16(v0[2], v0[3]); w.z = cvt_pk_bf16(v1[0], v1[1]); w.w = cvt_pk_bf16(v1[2], v1[3]);
                    *(v4u*)(rowp + bj * HALF) = w; } }
    }
};

struct EpiScaleF8 {
    static constexpr bool PERM = true;
    unsigned char* Y; int ldc; const float* wt; const LAS int* ecnt;
    __device__ __forceinline__ void operator()(const f32x4 (&acc)[2][2][4][2], const Unit& u, int wr, int wc, int fr, int fq) const {
        const int row0 = u.pm * BM + wr * 64 + fr, col0 = u.pn * BM + wc * 32 + 8 * fq;
        const int cnt = ecnt[u.e]; const float* wl = wt + (size_t)u.e * NTOK;
#pragma unroll
        for (int ai = 0; ai < 2; ++ai)
#pragma unroll
            for (int m = 0; m < 4; ++m) { const int lr = u.lt * 256 + wr * 64 + fr + ai * HALF + m * 16; const float s = lr < cnt ? wl[lr] * 16.f : 0.f;
                unsigned char* rowp = Y + (size_t)(row0 + ai * HALF + m * 16) * ldc + col0;
#pragma unroll
                for (int bj = 0; bj < 2; ++bj) { const f32x4 v0 = acc[ai][bj][m][0] * s, v1 = acc[ai][bj][m][1] * s;
                    int w0 = 0, w1 = 0;
                    w0 = cvt2_fp8(v0[0], v0[1], w0, false); w0 = cvt2_fp8(v0[2], v0[3], w0, true);
                    w1 = cvt2_fp8(v1[0], v1[1], w1, false); w1 = cvt2_fp8(v1[2], v1[3], w1, true);
                    *(v2u*)(rowp + bj * HALF) = (v2u){(unsigned)w0, (unsigned)w1}; } }
    }
};

template <class Epi, class Sched, bool ALIGN_EPI, bool FP8 = false>
__device__ __forceinline__ void gemm_phase(LAS unsigned char* lds, const Gemm g, const Sched& S, const Epi& E) {
    constexpr bool GA = Sched::GATHER;
    int tid_ = threadIdx.x; asm volatile("" : "+v"(tid_));
    const int tid = tid_, wid = __builtin_amdgcn_readfirstlane(tid >> 6), lane = tid & 63, wr = wid >> 2, wc = wid & 3, fr = lane & 15, fq = lane >> 4;
    const int K = g.K, nt = K / BK;
    unsigned voffA[2], voffB[2], gC[2]; int gR[2];
#pragma unroll
    for (int i = 0; i < 2; ++i) { int R, C; stage_rc(tid * 16 + i * 8192, R, C); const int Rb = Epi::PERM ? ((R & ~31) + perm32(R & 31)) : R;
        voffA[i] = (unsigned)(R * K + C) * 2u; voffB[i] = (unsigned)(Rb * K + C) * 2u; gR[i] = R; gC[i] = (unsigned)C * 2u; }
    const size_t kstep = (size_t)(BK * 2);
    const size_t hstep = (size_t)HALF * K * 2;
    const size_t H1 = GA ? 0 : hstep;
    const unsigned ldsw = (unsigned)wid * 1024u;
    const int aoff = lds_byte(wr * 64 + fr, fq * 8), boff = lds_byte(wc * 32 + fr, fq * 8);
    unsigned vA0[2], vA1[2], vT1[2];
#define PG8_LOADG(ui_) do { int tg_ = threadIdx.x; asm volatile("" : "+v"(tg_)); _Pragma("unroll") for (int _i = 0; _i < 2; ++_i) { int R_, C_; stage_rc(tg_ * 16 + _i * 8192, R_, C_); vA0[_i] = (unsigned)S.gidx((ui_), R_) * (unsigned)(K * 2) + (unsigned)C_ * 2u; vA1[_i] = (unsigned)S.gidx((ui_), HALF + R_) * (unsigned)(K * 2) + (unsigned)C_ * 2u; } } while (0)
    unsigned (&rA0)[2] = GA ? vA0 : voffA; unsigned (&rA1)[2] = GA ? vA1 : voffA; unsigned (&rT1)[2] = GA ? vT1 : voffA;
#define PG8_SA(b, h) (((b) * 2 + (h)) * HTB)
#define PG8_SB(b, h) ((4 + (b) * 2 + (h)) * HTB)
#define PG8_STAGE(bufoff, gbase, voff) do { unsigned long long gb_ = (unsigned long long)(gbase); asm volatile("" : "+s"(gb_));     \
        _Pragma("unroll") for (int _i = 0; _i < 2; ++_i) { unsigned vo_ = (voff)[_i]; asm volatile("" : "+v"(vo_));     \
        __builtin_amdgcn_global_load_lds((const unsigned*)((const char*)gb_ + vo_), (LAS unsigned*)(lds + (bufoff) + ldsw + _i * 8192), 16, 0, 0); } } while (0)
#define PG8_LDA(dst, b, h) do { _Pragma("unroll") for (int m = 0; m < 4; ++m) { if constexpr (FP8) { \
            dst##8[m].lo = *(const LAS v4i_*)(lds + PG8_SA(b, h) + aoff + m * 2048); dst##8[m].hi = *(const LAS v4i_*)(lds + PG8_SA(b, h) + aoff + m * 2048 + 1024); } \
        else { _Pragma("unroll") for (int k = 0; k < 2; ++k) dst[m][k] = *(const LAS bf16x8*)(lds + PG8_SA(b, h) + aoff + m * 2048 + k * 1024); } } } while (0)
#define PG8_LDB(dst, b, h) do { _Pragma("unroll") for (int n = 0; n < 2; ++n) { if constexpr (FP8) { \
            dst##8[n].lo = *(const LAS v4i_*)(lds + PG8_SB(b, h) + boff + n * 2048); dst##8[n].hi = *(const LAS v4i_*)(lds + PG8_SB(b, h) + boff + n * 2048 + 1024); } \
        else { _Pragma("unroll") for (int k = 0; k < 2; ++k) dst[n][k] = *(const LAS bf16x8*)(lds + PG8_SB(b, h) + boff + n * 2048 + k * 1024); } } } while (0)
#define PG8_MMA(ai, bj, At, Bt) do { __builtin_amdgcn_s_setprio(1); _Pragma("unroll") for (int m = 0; m < 4; ++m) _Pragma("unroll") for (int n = 0; n < 2; ++n) { \
        if constexpr (FP8) asm volatile("v_mfma_scale_f32_16x16x128_f8f6f4 %0, %1, %2, %0, %3, %4 op_sel_hi:[0,0,0]" : "+v"(acc[ai][bj][m][n]) : "v"(Bt##8[n]), "v"(At##8[m]), "v"(wsc_), "v"(one_));     \
        else { _Pragma("unroll") for (int k = 0; k < 2; ++k) acc[ai][bj][m][n] = __builtin_amdgcn_mfma_f32_16x16x32_bf16(Bt[n][k], At[m][k], acc[ai][bj][m][n], 0, 0, 0); } } \
        __builtin_amdgcn_s_setprio(0); } while (0)
#define PG8_WAIT_V(n) asm volatile("s_waitcnt vmcnt(" #n ")" ::: "memory")
#define PG8_WAIT_L(n) asm volatile("s_waitcnt lgkmcnt(" #n ")" ::: "memory")
#define PG8_BAR __builtin_amdgcn_s_barrier()
#define PG8_SCHED __builtin_amdgcn_sched_barrier(0)
    Unit cur, nxt; int ui = 0;
    if (!S.next(0, cur)) return;
    f32x4 acc[2][2][4][2];
#pragma unroll
    for (int a = 0; a < 2; ++a)
#pragma unroll
        for (int b = 0; b < 2; ++b)
#pragma unroll
            for (int m = 0; m < 4; ++m)
#pragma unroll
                for (int n = 0; n < 2; ++n) acc[a][b][m][n] = (f32x4){0.f, 0.f, 0.f, 0.f};
    typedef int v8i_ __attribute__((ext_vector_type(8))); typedef int v4i_ __attribute__((ext_vector_type(4)));
    const int wsc_ = (int)g.wscale, one_ = 0x7f7f7f7f;
    bf16x8 At[4][2], B0[2][2], B1[2][2]; v8i_ At8[4], B08[2], B18[2];
    const char* cA = S.a_base(g, cur); const char* cB = S.b_base(g, cur);
    if constexpr (GA) { PG8_LOADG(0); vT1[0] = vA1[0]; vT1[1] = vA1[1]; }
    PG8_STAGE(PG8_SB(0, 0), cB, voffB); PG8_STAGE(PG8_SB(0, 1), cB + hstep, voffB); PG8_STAGE(PG8_SA(0, 0), cA, rA0); PG8_STAGE(PG8_SA(0, 1), cA + H1, rA1);
    if (wr == 1) PG8_BAR;
    PG8_WAIT_V(2); PG8_BAR;
    PG8_STAGE(PG8_SB(1, 0), cB + kstep, voffB); PG8_STAGE(PG8_SA(1, 0), cA + kstep, rA0); PG8_STAGE(PG8_SB(1, 1), cB + hstep + kstep, voffB);
    PG8_WAIT_V(6); PG8_BAR;
    for (;;) {
        const bool has_next = S.next(ui + 1, nxt);
        const char* nA = has_next ? S.a_base(g, nxt) : cA; const char* nB = has_next ? S.b_base(g, nxt) : cB;
#pragma unroll 1
        for (int t = 0; t < nt; t += 2) {
            const bool last = (t == nt - 2);
            const char* a1 = cA + (size_t)(t + 1) * kstep;
            const char* a2 = last ? nA : cA + (size_t)(t + 2) * kstep; const char* b2 = last ? nB : cB + (size_t)(t + 2) * kstep;
            const char* a3 = a2 + kstep; const char* b3 = b2 + kstep;
            if constexpr (GA) { if (last && has_next) PG8_LOADG(ui + 1); }
            PG8_LDB(B0, 0, 0); PG8_LDB(B1, 0, 1); PG8_SCHED; PG8_LDA(At, 0, 0); PG8_STAGE(PG8_SA(1, 1), a1 + H1, rT1);
            PG8_WAIT_V(8); PG8_WAIT_L(0); PG8_BAR; PG8_MMA(0, 0, At, B0); PG8_MMA(0, 1, At, B1); PG8_BAR; PG8_SCHED;
            PG8_LDA(At, 0, 1); PG8_STAGE(PG8_SB(0, 0), b2, voffB); PG8_STAGE(PG8_SB(0, 1), b2 + hstep, voffB); PG8_STAGE(PG8_SA(0, 0), a2, rA0);
            PG8_WAIT_V(8); PG8_WAIT_L(0); PG8_BAR; PG8_MMA(1, 0, At, B0); PG8_MMA(1, 1, At, B1); PG8_BAR; PG8_SCHED;
            PG8_LDB(B0, 1, 0); PG8_LDB(B1, 1, 1); PG8_SCHED; PG8_LDA(At, 1, 0); PG8_STAGE(PG8_SA(0, 1), a2 + H1, rA1);
            PG8_WAIT_V(8); PG8_WAIT_L(0); PG8_BAR; PG8_MMA(0, 0, At, B0); PG8_MMA(0, 1, At, B1); PG8_BAR; PG8_SCHED;
            PG8_LDA(At, 1, 1); PG8_STAGE(PG8_SB(1, 0), b3, voffB); PG8_STAGE(PG8_SB(1, 1), b3 + hstep, voffB); PG8_STAGE(PG8_SA(1, 0), a3, rA0);
            PG8_WAIT_V(8); PG8_WAIT_L(0); PG8_BAR; PG8_MMA(1, 0, At, B0); PG8_MMA(1, 1, At, B1); PG8_BAR; PG8_SCHED;
        }
        if constexpr (FP8) asm volatile("s_nop 15\n\ts_nop 15" ::: "memory");
        if constexpr (ALIGN_EPI) { if (wr == 0) PG8_BAR; }
        E(acc, cur, wr, wc, fr, fq);
        if (!has_next) break;
#pragma unroll
        for (int a = 0; a < 2; ++a)
#pragma unroll
            for (int b = 0; b < 2; ++b)
#pragma unroll
                for (int m = 0; m < 4; ++m)
#pragma unroll
                    for (int n = 0; n < 2; ++n) acc[a][b][m][n] = (f32x4){0.f, 0.f, 0.f, 0.f};
        cur = nxt; cA = nA; cB = nB; ++ui;
        if constexpr (GA) { vT1[0] = vA1[0]; vT1[1] = vA1[1]; }
        if constexpr (ALIGN_EPI) { if (wr == 1) PG8_BAR; }
    }
    PG8_WAIT_V(0);
    if constexpr (!ALIGN_EPI) { if (wr == 0) PG8_BAR; }
    PG8_BAR;
#undef PG8_LOADG
#undef PG8_SA
#undef PG8_SB
#undef PG8_STAGE
#undef PG8_LDA
#undef PG8_LDB
#undef PG8_MMA
#undef PG8_WAIT_V
#undef PG8_WAIT_L
#undef PG8_BAR
#undef PG8_SCHED
}
}

constexpr size_t MiB = 1u << 20;
constexpr size_t WS_CTL = 0, CTL_ZERO_BYTES = 1 * MiB;
constexpr size_t SZ_WIN = (size_t)NP * DM * 2, SZ_WDT = (size_t)16 * DM * 2, SZ_WR = (size_t)48 * DM * 2, SZ_WOUT = (size_t)DM * DM * 2;
constexpr size_t SZ_WGU1 = (size_t)1024 * DM * 2, SZ_WD1 = (size_t)DM * DEXP * 2;
constexpr size_t WS_WIN = 1 * MiB;
constexpr size_t WS_WDT = WS_WIN + NLAYER * SZ_WIN;
constexpr size_t WS_WR = WS_WDT + NLAYER * SZ_WDT;
constexpr size_t WS_WOUT = WS_WR + NLAYER * SZ_WR;
constexpr size_t WS_WGU = WS_WOUT + NLAYER * SZ_WOUT;
constexpr size_t WS_WD = WS_WGU + NLAYER * NEXP * SZ_WGU1;
constexpr size_t WS_P = WS_WD + NLAYER * NEXP * SZ_WD1;
constexpr size_t SZ_P = (size_t)NTOK * NP * 2;
constexpr size_t WS_Y = WS_P, SZ_Y = (size_t)PADROWS * DM * 2;
constexpr size_t WS_HID = WS_Y + SZ_Y, SZ_HID = (size_t)PADROWS * DEXP * 2;
static_assert(SZ_Y + SZ_HID <= SZ_P, "Y|HID overlay P");
constexpr size_t WS_U = WS_P + SZ_P, SZ_U = (size_t)NTOK * DM * 2;
constexpr size_t WS_DT = WS_U + SZ_U, SZ_DT = (size_t)NTOK * 16 * 4;
constexpr size_t WS_TOK = WS_DT + SZ_DT, SZ_TOK = (size_t)NEXP * NTOK * 4;
constexpr size_t WS_WT = WS_TOK + SZ_TOK;
constexpr size_t WS_SLOT = WS_WT + SZ_TOK, SZ_SLOT = (size_t)NTOK * 2 * 4;
constexpr size_t WS_ROT = WS_SLOT + SZ_SLOT, SZ_ROT = (size_t)SEQ * 64 * 4;
constexpr size_t WS_XC = WS_ROT + 2 * SZ_ROT, SZ_XC = (size_t)NTOK * CONVD * 2;
constexpr size_t HPU = 16384 + 16384 + 8192 + 512;
constexpr size_t WS_HP = WS_XC + SZ_XC, SZ_HP = (size_t)32 * 32 * HPU;
constexpr size_t WS_U8 = WS_XC;
constexpr size_t WS_SD = WS_HP + SZ_HP, SZ_SD = (size_t)8 * 16 * SEQ * 16;
constexpr size_t WS_H = WS_SD + SZ_SD, SZ_H = (size_t)NTOK * DM * 2;
constexpr size_t WS_END = WS_H + SZ_H;
static_assert(WS_END < 1000000000ull, "workspace map");
constexpr int CW_BAR = 4096;
constexpr int CW_CNT = 8192;
constexpr int RING_BYTES = 131072, LDSCTL_OFF = RING_BYTES, MISC_OFF = LDSCTL_OFF + 320;
constexpr int TAB_OFF = RING_BYTES + 1024;
constexpr int T_TMAP = 0, T_ECNT = 192, T_EBASE = 224, T_GTAB = 256, T_END = 256 + 1024;
constexpr int LDS_BYTES = 147456;
static_assert(TAB_OFF + T_END * 4 <= LDS_BYTES, "LDS map");
constexpr int NWAVES = 8;

#define XB_TMO      128
#define XB_XCNT(j)  (256  + 64 * (j))
#define XB_XSUB(j)  (1280 + 64 * (j))
#define XB_XGEN(j)  (2304 + 64 * (j))
#define XB_TOP      3328
#define XB_TOPGEN   3392
#define XCD_BAR_WORDS 3456
#define XB_SPIN_CAP (1u << 18)
__device__ __forceinline__ unsigned xb_ld(unsigned* p)              { return __hip_atomic_load(p, __ATOMIC_RELAXED, __HIP_MEMORY_SCOPE_AGENT); }
__device__ __forceinline__ unsigned xb_add(unsigned* p, unsigned v) { return __hip_atomic_fetch_add(p, v, __ATOMIC_RELAXED, __HIP_MEMORY_SCOPE_AGENT); }
__device__ __forceinline__ unsigned xb_xcc_id() { return (unsigned)__builtin_amdgcn_s_getreg((3 << 11) | 20) & 0xFu; }
#define XB_SPIN(cond, bar) do { unsigned _sp = 0; while (cond) { __builtin_amdgcn_s_sleep(1); \
    if ((++_sp & 255u) == 0u) { if (xb_ld(&(bar)[XB_TMO])) break; if (_sp > XB_SPIN_CAP) { atomicAdd(&(bar)[XB_TMO], 1u); break; } } } } while (0)
struct XcdBarrier { unsigned* bar; unsigned x; volatile LAS unsigned* st; };
__device__ __forceinline__ XcdBarrier xcd_barrier_post(unsigned* bar, volatile LAS unsigned* st) {
    XcdBarrier b; b.bar = bar; b.x = xb_xcc_id(); b.st = st;
    if (threadIdx.x == 0) (void)xb_add(&bar[XB_XCNT(b.x)], 1u);
    return b;
}
__device__ __forceinline__ void xcd_barrier_complete(unsigned* bar, unsigned x, unsigned& nloc, unsigned& nx) {
    const unsigned G = gridDim.x * gridDim.y * gridDim.z;
    unsigned sum, cnt, mine, sp = 0u;
    for (;;) {
        sum = 0u; cnt = 0u; mine = 0u;
#pragma unroll
        for (unsigned j = 0; j < 16; ++j) { const unsigned c = xb_ld(&bar[XB_XCNT(j)]); sum += c; cnt += (c > 0u) ? 1u : 0u; mine = (j == x) ? c : mine; }
        if (sum == G) break;
        __builtin_amdgcn_s_sleep(1);
        if ((++sp & 255u) == 0u) { if (xb_ld(&bar[XB_TMO])) break; if (sp > XB_SPIN_CAP) { atomicAdd(&bar[XB_TMO], 1u); break; } }
    }
    nloc = mine > 0u ? mine : 1u; nx = cnt > 0u ? cnt : 1u;
}
__device__ __forceinline__ void xcd_barrier(const XcdBarrier& b) {
    asm volatile("s_waitcnt vmcnt(0)" ::: "memory");
    __syncthreads();
    if (threadIdx.x == 0) {
        unsigned* bar = b.bar;
        __builtin_amdgcn_s_waitcnt(0);
        unsigned nloc = b.st[0], nx = b.st[1];
        if (nloc == 0u) { xcd_barrier_complete(bar, b.x, nloc, nx); b.st[0] = nloc; b.st[1] = nx; }
        const unsigned old = xb_add(&bar[XB_XSUB(b.x)], 1u);
        const unsigned gen = old / nloc;
        if (old + 1u == (gen + 1u) * nloc) {
            __builtin_amdgcn_fence(__ATOMIC_RELEASE, "agent");
            asm volatile("s_waitcnt vmcnt(0)" ::: "memory");
            const unsigned og = xb_add(&bar[XB_TOP], 1u);
            const unsigned tg = og / nx;
            if (og + 1u == (tg + 1u) * nx) xb_add(&bar[XB_TOPGEN], 1u);
            else XB_SPIN(xb_ld(&bar[XB_TOPGEN]) == tg, bar);
            __builtin_amdgcn_fence(__ATOMIC_ACQUIRE, "agent");
            xb_add(&bar[XB_XGEN(b.x)], 1u);
            asm volatile("s_waitcnt vmcnt(0)" ::: "memory");
        } else {
            XB_SPIN(xb_ld(&bar[XB_XGEN(b.x)]) == gen, bar);
            __builtin_amdgcn_fence(__ATOMIC_ACQUIRE, "agent");
            asm volatile("s_waitcnt vmcnt(0)" ::: "memory");
        }
    }
    __syncthreads();
}

struct Args { const float* in[21]; float* out; unsigned char* ws; int gp_lo, gp_hi; };
struct Frame {
    LAS unsigned char* lds;
    volatile LAS unsigned* MISC;
    LAS int* tab;
    unsigned* ctl;
    int tid, lane, wave, G, bid;
    float* out; unsigned char* ws;
};
enum { I_X = 0, I_ANW, I_WIN, I_CONVW, I_CONVB, I_DTB, I_ALOG, I_SSDD, I_SSDNW, I_HLB, I_HNW, I_WOUT, I_FNW, I_RGW, I_RGB, I_REW, I_REB, I_EWG, I_EWU, I_EWD, I_FINW };

__device__ __forceinline__ int gt0(const Frame& F) { return F.bid * (NWAVES * 64) + F.tid; }
struct TItem { const float* W; bf16* base; int N, K, kind, up, k0, n0; float sc; };
__device__ __forceinline__ bf16* titem_row(const TItem& t, int n) {
    if (n >= t.N) return nullptr;
    if (t.kind == 0) { if (n < DT_COL0) return t.base + (size_t)n * DM; if (n < DT_COL0 + 16) return nullptr; return t.base + (size_t)(n - 16) * DM; }
    if (t.kind == 1) return t.base + (size_t)n * t.K;
    return t.base + (size_t)((n >> 7) * 256 + t.up * 128 + (n & 127)) * DM;
}
constexpr int TI_IN = 32 * 209, TI_OUT = 32 * 64, TI_G = 32 * 16, TI_D = 8 * 64, TI_LAYER = TI_IN + TI_OUT + NEXP * (2 * TI_G + TI_D);
__device__ __forceinline__ void titem_decode(const Frame& F, const Args& A, int it, TItem& t) {
    const int l = it / TI_LAYER; int r = it - l * TI_LAYER; t.up = 0; t.sc = 1.f;
    if (r < TI_IN) { t.W = A.in[I_WIN] + (size_t)l * DM * IN_DIM; t.base = (bf16*)(F.ws + WS_WIN + l * SZ_WIN); t.N = IN_DIM; t.K = DM; t.kind = 0; }
    else if ((r -= TI_IN) < TI_OUT) { t.W = A.in[I_WOUT] + (size_t)l * DM * DM; t.base = (bf16*)(F.ws + WS_WOUT + l * SZ_WOUT); t.N = DM; t.K = DM; t.kind = 1; }
    else { r -= TI_OUT; const int e = r / (2 * TI_G + TI_D); r -= e * (2 * TI_G + TI_D); const size_t eo = (size_t)(l * NEXP + e);
        if (r < TI_G) { t.W = A.in[I_EWG] + eo * DM * DEXP; t.base = (bf16*)(F.ws + WS_WGU + eo * SZ_WGU1); t.N = DEXP; t.K = DM; t.kind = MOE_FP8 ? 3 : 2; t.sc = 64.f; }
        else if ((r -= TI_G) < TI_G) { t.W = A.in[I_EWU] + eo * DM * DEXP; t.base = (bf16*)(F.ws + WS_WGU + eo * SZ_WGU1); t.N = DEXP; t.K = DM; t.kind = MOE_FP8 ? 3 : 2; t.up = 1; t.sc = 64.f; }
        else { r -= TI_G; t.W = A.in[I_EWD] + eo * DEXP * DM; t.base = (bf16*)(F.ws + WS_WD + eo * SZ_WD1); t.N = DM; t.K = DEXP; t.kind = MOE_FP8 ? 4 : 1; t.sc = 32.f; } }
    const int nblk = (t.N + 31) / 32, kb = r / nblk, nb = r - kb * nblk; t.k0 = 64 * kb; t.n0 = 32 * nb;
}
__device__ __forceinline__ void titem_load(const TItem& t, f32x4 (&v)[8], int lane) {
    const int kq = lane >> 3, nc = t.n0 + 4 * (lane & 7); const bool ok = nc < t.N;
#pragma unroll
    for (int j = 0; j < 8; ++j) v[j] = ok ? *(const f32x4*)(t.W + (size_t)(t.k0 + kq + 8 * j) * t.N + nc) : (f32x4){0.f, 0.f, 0.f, 0.f};
}
__device__ __forceinline__ void titem_store(const TItem& t, const f32x4 (&v)[8], LAS float* scr, int lane) {
    const int kq = lane >> 3, c4 = lane & 7;
#pragma unroll
    for (int j = 0; j < 8; ++j)
#pragma unroll
        for (int e = 0; e < 4; ++e) scr[(kq + 8 * j) * 33 + 4 * c4 + e] = v[j][e];
    LDS_WAIT(); asm volatile("" ::: "memory");
    if (t.kind >= 3) {
        const int n = lane & 31, hf = lane >> 5; const LAS float* s = scr + (32 * hf) * 33 + n; v4u o[2];
#pragma unroll
        for (int q = 0; q < 8; ++q) { int w_ = 0;
            w_ = cvt2_fp8(s[(4 * q + 0) * 33] * t.sc, s[(4 * q + 1) * 33] * t.sc, w_, false);
            w_ = cvt2_fp8(s[(4 * q + 2) * 33] * t.sc, s[(4 * q + 3) * 33] * t.sc, w_, true);
            o[q >> 2][q & 3] = (unsigned)w_; }
        const int nn = t.n0 + n;
        if (nn < t.N) { unsigned char* dst = (unsigned char*)t.base + (t.kind == 3 ? (size_t)((nn >> 7) * 256 + t.up * 128 + (nn & 127)) * DM : (size_t)nn * t.K) + t.k0 + 32 * hf;
            *(v4u*)dst = o[0]; *(v4u*)(dst + 16) = o[1]; }
        LDS_WAIT(); asm volatile("" ::: "memory");
        return;
    }
    const int c = lane & 7;
#pragma unroll
    for (int j = 0; j < 4; ++j) { const int n = (lane >> 3) + 8 * j; const LAS float* s = scr + (8 * c) * 33 + n;
        v4u o; o.x = pk2(s[0 * 33], s[1 * 33]); o.y = pk2(s[2 * 33], s[3 * 33]); o.z = pk2(s[4 * 33], s[5 * 33]); o.w = pk2(s[6 * 33], s[7 * 33]);
        bf16* dst = titem_row(t, t.n0 + n); if (dst) *(v4u*)(dst + t.k0 + 8 * c) = o; }
    LDS_WAIT(); asm volatile("" ::: "memory");
}
#ifndef CONV_SPLIT_ITEMS
#define CONV_SPLIT_ITEMS 20000
#endif
constexpr int CONV_SPLIT = CONV_SPLIT_ITEMS;
#ifndef CT_ITEMS
#define CT_ITEMS 20000
#endif
constexpr int CT_LO = NLAYER * (32 * 209 + 32 * 64 + NEXP * (2 * 32 * 16 + 8 * 64)) - CT_ITEMS;
constexpr int G1_WGS = 192;
static_assert(CONV_SPLIT >= TI_IN && CONV_SPLIT <= NLAYER * TI_LAYER, "conversion split");
__device__ __forceinline__ void convert_items(Frame& F, const Args& A, int lo, int hi, int gw, int NGW) {
    LAS float* scr = (LAS float*)(F.lds + F.wave * 16384);
    for (int it = lo + gw; it < hi; it += 4 * NGW) {
        TItem t0, t1, t2, t3; f32x4 v0[8], v1[8], v2[8], v3[8];
        const bool h1 = it + NGW < hi, h2 = it + 2 * NGW < hi, h3 = it + 3 * NGW < hi;
        titem_decode(F, A, it, t0); titem_load(t0, v0, F.lane);
        if (h1) { titem_decode(F, A, it + NGW, t1); titem_load(t1, v1, F.lane); }
        if (h2) { titem_decode(F, A, it + 2 * NGW, t2); titem_load(t2, v2, F.lane); }
        if (h3) { titem_decode(F, A, it + 3 * NGW, t3); titem_load(t3, v3, F.lane); }
        titem_store(t0, v0, scr, F.lane);
        if (h1) titem_store(t1, v1, scr, F.lane);
        if (h2) titem_store(t2, v2, scr, F.lane);
        if (h3) titem_store(t3, v3, scr, F.lane);
    }
}
__device__ __forceinline__ void phase_prologue(Frame& F, const Args& A) {
    const int gw = F.bid * NWAVES + F.wave, NGW = F.G * NWAVES;
    convert_items(F, A, 0, CONV_SPLIT, gw, NGW);
    for (int i = gt0(F); i < SEQ * 64; i += F.G * NWAVES * 64) { const int pos = i >> 6, ri = i & 63; float sn, cs; sincosf((float)pos * powf(10000.f, -(float)ri / 64.f), &sn, &cs);
        ((float*)(F.ws + WS_ROT))[i] = cs; ((float*)(F.ws + WS_ROT + SZ_ROT))[i] = sn; }
    const int gt = F.bid * (NWAVES * 64) + F.tid, NGT = F.G * NWAVES * 64;
    for (int i = gt; i < NLAYER * 16 * DM; i += NGT) { const int l = i / (16 * DM), j = (i / DM) % 16, k = i % DM;
        ((bf16*)(F.ws + WS_WDT))[i] = (bf16)f2bf(A.in[I_WIN][(size_t)l * DM * IN_DIM + (size_t)k * IN_DIM + DT_COL0 + j]); }
    for (int i = gt; i < NLAYER * 48 * DM; i += NGT) { const int l = i / (48 * DM), j = (i / DM) % 48, k = i % DM;
        float v = 0.f; if (j < 4) v = A.in[I_RGW][((size_t)l * DM + k) * 4 + j]; else if (j < 36) v = A.in[I_REW][((size_t)l * DM + k) * 32 + (j - 4)];
        ((bf16*)(F.ws + WS_WR))[i] = (bf16)f2bf(v); }
}

template <int NCT>
__device__ __forceinline__ void mini_gemm16(const bf16* A, const bf16* Bt, f32x4 (&acc)[NCT], int lane) {
    const int fr = lane & 15, fq = lane >> 4;
#pragma unroll
    for (int c = 0; c < NCT; ++c) acc[c] = (f32x4){0.f, 0.f, 0.f, 0.f};
    const bf16* ap = A + (size_t)fr * DM + fq * 8; const bf16* bp = Bt + (size_t)fr * DM + fq * 8;
#pragma unroll 4
    for (int ks = 0; ks < DM / 32; ++ks) {
        const bf16x8 a = *(const bf16x8*)(ap + ks * 32);
#pragma unroll
        for (int c = 0; c < NCT; ++c) { const bf16x8 b = *(const bf16x8*)(bp + (size_t)c * 16 * DM + ks * 32); acc[c] = __builtin_amdgcn_mfma_f32_16x16x32_bf16(a, b, acc[c], 0, 0, 0); }
    }
}

__device__ __forceinline__ void build_tables(Frame& F, int l) {
    if (F.tid == 0) { int run = 0;
        for (int e = 0; e < NEXP; ++e) { const int c = (int)__hip_atomic_load(F.ctl + CW_CNT + (l * NEXP + e) * 64, RLX_AGENT); const int nt = (c + 255) >> 8;
            F.tab[T_ECNT + e] = c; F.tab[T_EBASE + e] = run; for (int t = 0; t < nt; ++t) F.tab[T_TMAP + run + t] = (e << 8) | t; run += nt; }
        F.MISC[16] = (unsigned)run; }
    __syncthreads();
}

template <int MODE, int NR, bool F8 = false, bool HB = false>
__device__ __forceinline__ void norm_rows(const float* const (&src)[NR], float* const (&hdst)[NR], const bf16* const (&y0)[NR], const bf16* const (&y1)[NR], const f32x4 (&wv)[8], bf16* const (&udst)[NR], float* const (&fdst)[NR], int lane, unsigned char* const* u8 = nullptr) {
    f32x4 v[NR][8];
#pragma unroll
    for (int q = 0; q < NR; ++q)
#pragma unroll
        for (int j = 0; j < 8; ++j) { if constexpr (HB) { const v2u h_ = ((const v2u*)src[q] + lane)[64 * j]; v[q][j] = (f32x4){__uint_as_float(h_.x << 16), __uint_as_float(h_.x & 0xffff0000u), __uint_as_float(h_.y << 16), __uint_as_float(h_.y & 0xffff0000u)}; }
            else v[q][j] = ((const f32x4*)src[q] + lane)[64 * j]; }
    if (MODE >= 1) {
#pragma unroll
        for (int q = 0; q < NR; ++q) {
#if MOE_FP8
            unsigned ya[8], yb[8];
#pragma unroll
            for (int j = 0; j < 8; ++j) { ya[j] = *((const unsigned*)y0[q] + lane + 64 * j); yb[j] = *((const unsigned*)y1[q] + lane + 64 * j); }
#pragma unroll
            for (int j = 0; j < 8; ++j) { const f32x2 a0 = __builtin_amdgcn_cvt_pk_f32_fp8((int)ya[j], false), a1 = __builtin_amdgcn_cvt_pk_f32_fp8((int)ya[j], true), b0 = __builtin_amdgcn_cvt_pk_f32_fp8((int)yb[j], false), b1 = __builtin_amdgcn_cvt_pk_f32_fp8((int)yb[j], true);
                v[q][j][0] += (a0.x + b0.x) * 0.0625f; v[q][j][1] += (a0.y + b0.y) * 0.0625f; v[q][j][2] += (a1.x + b1.x) * 0.0625f; v[q][j][3] += (a1.y + b1.y) * 0.0625f; }
#else
            v2u ya[8], yb[8];
#pragma unroll
            for (int j = 0; j < 8; ++j) { ya[j] = *((const v2u*)y0[q] + lane + 64 * j); yb[j] = *((const v2u*)y1[q] + lane + 64 * j); }
#pragma unroll
            for (int j = 0; j < 8; ++j) { const v2u a = ya[j], b = yb[j];
                v[q][j][0] += __uint_as_float(a.x << 16) + __uint_as_float(b.x << 16); v[q][j][1] += __uint_as_float(a.x & 0xffff0000u) + __uint_as_float(b.x & 0xffff0000u);
                v[q][j][2] += __uint_as_float(a.y << 16) + __uint_as_float(b.y << 16); v[q][j][3] += __uint_as_float(a.y & 0xffff0000u) + __uint_as_float(b.y & 0xffff0000u); }
#endif
        }
    }
#pragma unroll
    for (int q = 0; q < NR; ++q) {
        if (MODE == 1) {
#pragma unroll
            for (int j = 0; j < 8; ++j) { if constexpr (HB) { v2u p; p.x = pk2(v[q][j][0], v[q][j][1]); p.y = pk2(v[q][j][2], v[q][j][3]); ((v2u*)hdst[q] + lane)[64 * j] = p;
                    v[q][j] = (f32x4){__uint_as_float(p.x << 16), __uint_as_float(p.x & 0xffff0000u), __uint_as_float(p.y << 16), __uint_as_float(p.y & 0xffff0000u)}; }
                else ((f32x4*)hdst[q] + lane)[64 * j] = v[q][j]; }
        }
        float s = 0.f;
#pragma unroll
        for (int j = 0; j < 8; ++j) s += (v[q][j][0] * v[q][j][0] + v[q][j][1] * v[q][j][1]) + (v[q][j][2] * v[q][j][2] + v[q][j][3] * v[q][j][3]);
        const float rstd = 1.f / sqrtf(wave_sum(s) * (1.f / DM) + EPS);
#pragma unroll
        for (int j = 0; j < 8; ++j) { const f32x4 o = v[q][j] * rstd * wv[j];
            if (MODE == 2) ((f32x4*)fdst[q] + lane)[64 * j] = o;
            else { v2u p; p.x = pk2(o[0], o[1]); p.y = pk2(o[2], o[3]); ((v2u*)udst[q] + lane)[64 * j] = p;
                if constexpr (F8) { int w_ = 0; w_ = cvt2_fp8(o[0], o[1], w_, false); w_ = cvt2_fp8(o[2], o[3], w_, true); ((unsigned*)u8[q] + lane)[64 * j] = (unsigned)w_; } } }
    }
}
__device__ __forceinline__ void load_normw(const float* w, f32x4 (&wv)[8], int lane) {
#pragma unroll
    for (int j = 0; j < 8; ++j) wv[j] = ((const f32x4*)w + lane)[64 * j];
}

__device__ __forceinline__ void phase_norm1(Frame& F, const Args& A, int l) {
    bf16* U = (bf16*)(F.ws + WS_U); const bf16* Y = (const bf16*)(F.ws + WS_Y); const int* slot = (const int*)(F.ws + WS_SLOT);
    f32x4 wv[8]; load_normw(A.in[I_ANW] + l * DM, wv, F.lane);
    if (l > 0) build_tables(F, l - 1);
    for (int blk = F.bid; blk < NTOK / 64; blk += F.G) {
        const int row0 = blk * 64;
        for (int r = 0; r < 8; r += 2) { const int row = row0 + F.wave * 8 + r;
            const float* src[2]; float* hd[2]; const bf16* ya[2]; const bf16* yb[2]; bf16* ud[2]; float* fd[2] = {nullptr, nullptr};
#pragma unroll
            for (int q = 0; q < 2; ++q) { const int rw = row + q; ud[q] = U + (size_t)rw * DM;
                if (l == 0) { src[q] = A.in[I_X] + (size_t)rw * DM; hd[q] = nullptr; ya[q] = nullptr; yb[q] = nullptr; }
                else { const int s0 = slot[rw * 2], s1 = slot[rw * 2 + 1];
                    ya[q] = Y + ((size_t)F.tab[T_EBASE + (s0 >> 16)] * 256 + (s0 & 0xffff)) * (MOE_FP8 ? DM / 2 : DM); yb[q] = Y + ((size_t)F.tab[T_EBASE + (s1 >> 16)] * 256 + (s1 & 0xffff)) * (MOE_FP8 ? DM / 2 : DM);
                    src[q] = H_BF16 ? (const float*)((const bf16*)(F.ws + WS_H) + (size_t)rw * DM) : F.out + (size_t)rw * DM; hd[q] = H_BF16 ? (float*)((bf16*)(F.ws + WS_H) + (size_t)rw * DM) : F.out + (size_t)rw * DM; } }
            if (l == 0) norm_rows<0, 2>(src, hd, ya, yb, wv, ud, fd, F.lane); else norm_rows<1, 2, false, H_BF16>(src, hd, ya, yb, wv, ud, fd, F.lane);
        }
        VM_WAIT(); __syncthreads();
        if (F.wave < 4) { f32x4 acc[1]; const int rb = row0 + F.wave * 16;
            mini_gemm16<1>(U + (size_t)rb * DM, (const bf16*)(F.ws + WS_WDT + l * SZ_WDT), acc, F.lane);
            float* DT = (float*)(F.ws + WS_DT);
#pragma unroll
            for (int j = 0; j < 4; ++j) DT[(size_t)(rb + (F.lane >> 4) * 4 + j) * 16 + (F.lane & 15)] = acc[0][j]; }
    }
}

__device__ __forceinline__ void phase_norm2(Frame& F, const Args& A, int l) {
    bf16* U = (bf16*)(F.ws + WS_U); f32x4 wv[8]; load_normw(A.in[I_FNW] + l * DM, wv, F.lane);
    LAS float* lg = (LAS float*)F.lds;
    LAS int* s_e = (LAS int*)(F.lds + 16384); LAS float* s_w = (LAS float*)(F.lds + 16384 + 512); LAS int* s_rank = (LAS int*)(F.lds + 16384 + 1024);
    LAS int* lcnt = (LAS int*)(F.lds + 16384 + 1536); LAS int* lbase = (LAS int*)(F.lds + 16384 + 1664);
    int* tokl = (int*)(F.ws + WS_TOK); float* wtl = (float*)(F.ws + WS_WT); int* slot = (int*)(F.ws + WS_SLOT);
    for (int blk = F.bid; blk < NTOK / 64; blk += F.G) {
        const int row0 = blk * 64;
        for (int r = 0; r < 8; r += 2) { const int row = row0 + F.wave * 8 + r;
            const float* src[2] = {H_BF16 ? (const float*)((const bf16*)(F.ws + WS_H) + (size_t)row * DM) : F.out + (size_t)row * DM, H_BF16 ? (const float*)((const bf16*)(F.ws + WS_H) + (size_t)(row + 1) * DM) : F.out + (size_t)(row + 1) * DM}; float* hd[2] = {nullptr, nullptr}; const bf16* ya[2] = {nullptr, nullptr};
            bf16* ud[2] = {U + (size_t)row * DM, U + (size_t)(row + 1) * DM}; float* fd[2] = {nullptr, nullptr};
            unsigned char* u8[2] = {F.ws + WS_U8 + (size_t)row * DM, F.ws + WS_U8 + (size_t)(row + 1) * DM};
            if (MOE_FP8) norm_rows<0, 2, true, H_BF16>(src, hd, ya, ya, wv, ud, fd, F.lane, u8); else norm_rows<0, 2, false, H_BF16>(src, hd, ya, ya, wv, ud, fd, F.lane); }
        if (F.tid < 32) lcnt[F.tid] = 0;
        VM_WAIT(); __syncthreads();
        if (F.wave < 4) { f32x4 acc[3]; const int rb = F.wave * 16;
            mini_gemm16<3>(U + (size_t)(row0 + rb) * DM, (const bf16*)(F.ws + WS_WR + l * SZ_WR), acc, F.lane);
#pragma unroll
            for (int c = 0; c < 3; ++c)
#pragma unroll
                for (int j = 0; j < 4; ++j) lg[(rb + (F.lane >> 4) * 4 + j) * 48 + c * 16 + (F.lane & 15)] = acc[c][j]; }
        __syncthreads();
        if (F.tid < 64) { const LAS float* L = lg + F.tid * 48;
            const float* bg = A.in[I_RGB] + l * 4; const float* be = A.in[I_REB] + l * 32;
            float gl[4]; int g = 0;
#pragma unroll
            for (int j = 0; j < 4; ++j) gl[j] = L[j] + bg[j];
#pragma unroll
            for (int j = 1; j < 4; ++j) if (gl[j] > gl[g]) g = j;
            float den = 0.f;
#pragma unroll
            for (int j = 0; j < 4; ++j) den += __expf(gl[j] - gl[g]);
            const float gate = 1.f / den;
            float el[8];
#pragma unroll
            for (int j = 0; j < 8; ++j) el[j] = L[4 + g * 8 + j] + be[g * 8 + j];
            int i1 = 0;
#pragma unroll
            for (int j = 1; j < 8; ++j) if (el[j] > el[i1]) i1 = j;
            int i2 = (i1 == 0) ? 1 : 0;
#pragma unroll
            for (int j = 0; j < 8; ++j) if (j != i1 && el[j] > el[i2]) i2 = j;
            const float w1 = gate / (1.f + __expf(el[i2] - el[i1])), w2 = gate - w1;
            s_e[2 * F.tid] = g * 8 + i1; s_e[2 * F.tid + 1] = g * 8 + i2; s_w[2 * F.tid] = w1; s_w[2 * F.tid + 1] = w2; }
        __syncthreads();
        if (F.tid < 128) s_rank[F.tid] = __hip_atomic_fetch_add(lcnt + s_e[F.tid], 1, __ATOMIC_RELAXED, __HIP_MEMORY_SCOPE_WORKGROUP);
        __syncthreads();
        if (F.tid < 32) { const int c = lcnt[F.tid]; lbase[F.tid] = c ? (int)__hip_atomic_fetch_add(F.ctl + CW_CNT + (l * NEXP + F.tid) * 64, (unsigned)c, RLX_AGENT) : 0; }
        __syncthreads();
        if (F.tid < 128) { const int e = s_e[F.tid], pos = lbase[e] + s_rank[F.tid], tok = row0 + (F.tid >> 1);
            tokl[(size_t)e * NTOK + pos] = tok; wtl[(size_t)e * NTOK + pos] = s_w[F.tid]; slot[tok * 2 + (F.tid & 1)] = (e << 16) | pos; }
        __syncthreads();
    }
}

enum { MX_RET = 0, MX_SSD = 1, MX_HGRN = 2 };
constexpr int IM_QA = 0, IM_QB = 16384, IM_KB = 32768, IM_KS = 73728, IM_V = 90112, IM_VS = 98304, IM_P = 106496, IM_ST = 114688;
constexpr int SM_CUM = TAB_OFF + T_END * 4, SM_TOT = SM_CUM + 512, SM_LAST = SM_TOT + 2048, SM_CW = SM_LAST + 512, SM_END = SM_CW + 6400;
static_assert(IM_ST + 16384 <= RING_BYTES && SM_END <= LDS_BYTES, "mixer LDS map");
typedef short s16x4 __attribute__((ext_vector_type(4)));
__device__ __forceinline__ unsigned img256(unsigned r, unsigned ch) { return 256u * r + 16u * (ch ^ (((r & 3u) << 2) | ((r >> 2) & 3u))); }
__device__ __forceinline__ unsigned imgP(unsigned r, unsigned ch) { return 128u * r + 16u * (ch ^ ((r >> 1) & 7u)); }
__device__ __forceinline__ unsigned imgV(unsigned r, unsigned ch) { return 128u * r + 16u * (ch ^ ((((r >> 1) & 1u) | (((r >> 3) & 1u) << 1)) << 1)); }
__device__ __forceinline__ bf16x8 tr_pair(LAS unsigned char* base, unsigned a0, unsigned a1) {
    const s16x4 lo = __builtin_amdgcn_ds_read_tr16_b64_v4i16((LAS s16x4*)(base + a0));
    const s16x4 hi = __builtin_amdgcn_ds_read_tr16_b64_v4i16((LAS s16x4*)(base + a1));
    return __builtin_shufflevector(lo, hi, 0, 1, 2, 3, 4, 5, 6, 7);
}
__device__ __forceinline__ void unpack8(const v4u x, float (&f)[8]) {
    f[0] = __uint_as_float(x.x << 16); f[1] = __uint_as_float(x.x & 0xffff0000u); f[2] = __uint_as_float(x.y << 16); f[3] = __uint_as_float(x.y & 0xffff0000u);
    f[4] = __uint_as_float(x.z << 16); f[5] = __uint_as_float(x.z & 0xffff0000u); f[6] = __uint_as_float(x.w << 16); f[7] = __uint_as_float(x.w & 0xffff0000u); }
__device__ __forceinline__ v4u pack8(const float (&f)[8]) { v4u w; w.x = pk2(f[0], f[1]); w.y = pk2(f[2], f[3]); w.z = pk2(f[4], f[5]); w.w = pk2(f[6], f[7]); return w; }


__device__ __forceinline__ void phase_conv(Frame& F, const Args& A, int l) {
    const bf16* P = (const bf16*)(F.ws + WS_P); bf16* XC = (bf16*)(F.ws + WS_XC);
    const float* cw = A.in[I_CONVW] + l * 4 * CONVD; const float* cb = A.in[I_CONVB] + l * CONVD;
    const int gt = F.bid * (NWAVES * 64) + F.tid, NGT = F.G * NWAVES * 64;
    for (int it = gt; it < (NTOK / 16) * 192; it += NGT) {
        const int rb = it / 192, cch = it - rb * 192, ch0 = cch * 8, row0 = rb * 16, tseq = row0 & (SEQ - 1);
        float cwr[4][8], cbr[8];
#pragma unroll
        for (int j = 0; j < 4; ++j) { const f32x4 a0 = *(const f32x4*)(cw + j * CONVD + ch0), a1 = *(const f32x4*)(cw + j * CONVD + ch0 + 4);
#pragma unroll
            for (int e = 0; e < 4; ++e) { cwr[j][e] = a0[e]; cwr[j][4 + e] = a1[e]; } }
        { const f32x4 b0 = *(const f32x4*)(cb + ch0), b1 = *(const f32x4*)(cb + ch0 + 4);
#pragma unroll
            for (int e = 0; e < 4; ++e) { cbr[e] = b0[e]; cbr[4 + e] = b1[e]; } }
        v4u xr[19];
#pragma unroll
        for (int rr = 0; rr < 19; ++rr) xr[rr] = (tseq + rr - 3 >= 0) ? *(const v4u*)(P + PB((size_t)(row0 + rr - 3), C_SX + ch0)) : (v4u){0u, 0u, 0u, 0u};
        float xs[4][8];
        unpack8(xr[0], xs[0]); unpack8(xr[1], xs[1]); unpack8(xr[2], xs[2]);
#pragma unroll
        for (int e = 0; e < 16; ++e) { float acc[8];
            unpack8(xr[e + 3], xs[(e + 3) & 3]);
#pragma unroll
            for (int c = 0; c < 8; ++c) acc[c] = cbr[c];
#pragma unroll
            for (int j = 0; j < 4; ++j)
#pragma unroll
                for (int c = 0; c < 8; ++c) acc[c] = fmaf(cwr[j][c], xs[(e + j) & 3][c], acc[c]);
#pragma unroll
            for (int c = 0; c < 8; ++c) acc[c] = siluf(acc[c]);
            *(v4u*)(XC + (size_t)(row0 + e) * CONVD + ch0) = pack8(acc); }
    }
}
#define IM_HCOPY(p) ((p) < 1024 ? IM_QB + (p) * 16 : ((p) < 2048 ? IM_KS + ((p) - 1024) * 16 : IM_P + ((p) - 2048) * 16))
#define MIX_BAR() do { asm volatile("s_waitcnt lgkmcnt(0)" ::: "memory"); __builtin_amdgcn_s_barrier(); asm volatile("" ::: "memory"); } while (0)

__device__ __forceinline__ void hgrn_prep_unit(Frame& F, const Args& A, int l, int b, int h, int n) {
    LAS unsigned char* lds = F.lds;
    const bf16* P = (const bf16*)(F.ws + WS_P);
    LAS float* totv = (LAS float*)(lds + SM_TOT); LAS float* lastv = (LAS float*)(lds + SM_LAST);
    const int tid = F.tid, w = F.wave;
    int lz = F.lane; asm volatile("" : "+v"(lz));
    const int fr = lz & 15, g = lz >> 4;
    const int ia = w >> 1, cc0 = (w & 1) * 2;
    const size_t row0 = (size_t)b * SEQ + n * 64;
    const int kk = tid & 127, sa = w >> 1;
    float hlb = 0.f;
    if (l > 0) { const float x0 = A.in[I_HLB][h * 128 + kk], x1 = A.in[I_HLB][512 + h * 128 + kk]; hlb = __builtin_amdgcn_rcpf(1.f + __expf(x0 - x1)); }
    const float hlbf = fmaxf(hlb, 1e-30f);
    bf16 hq[16], hf[16];
#pragma unroll
    for (int r = 0; r < 16; ++r) { const size_t pr_ = row0 + 16 * sa + r; hq[r] = P[PB(pr_, C_HQ + h * 128 + kk)]; hf[r] = P[PB(pr_, C_HF + h * 128 + kk)]; }
    float qv[16], kv[16], plr[16]; float pl = 1.f;
#pragma unroll
    for (int r = 0; r < 16; ++r) {
        const float qx = bf2f(hq[r]), fx = bf2f(hf[r]);
        const float sg = sigmf(fx);
        qv[r] = siluf(qx) * 0.08838834764831845f; kv[r] = (1.f - hlb) * (1.f - sg); pl *= hlbf + (1.f - hlb) * sg; plr[r] = pl; }
    totv[sa * 128 + kk] = pl;
    MIX_BAR();
    const float tt0 = totv[kk], tt1 = totv[128 + kk], tt2 = totv[256 + kk], tt3 = totv[384 + kk];
    if (sa == 0) lastv[kk] = tt0 * tt1 * tt2 * tt3;
    const float Ra = sa == 0 ? 1.f : (sa == 1 ? tt0 : (sa == 2 ? tt0 * tt1 : tt0 * tt1 * tt2));
    const float Ua = sa == 0 ? tt0 * tt1 * tt2 * tt3 : (sa == 1 ? tt1 * tt2 * tt3 : (sa == 2 ? tt2 * tt3 : tt3));
    const unsigned cb2 = (unsigned)(kk & 7) * 2u, chk = (unsigned)kk >> 3;
#pragma unroll
    for (int r = 0; r < 16; ++r) { const unsigned t = 16 * sa + r; const float qa = qv[r] * plr[r], ik = kv[r] * __builtin_amdgcn_rcpf(fmaxf(plr[r], 1e-30f));
        *(LAS bf16*)(lds + IM_QA + img256(t, chk) + cb2) = f2bf1(qa);
        *(LAS bf16*)(lds + IM_QB + img256(t, chk) + cb2) = f2bf1(qa * Ra);
        *(LAS bf16*)(lds + IM_KS + img256(t, chk) + cb2) = f2bf1(ik * Ua);
        float m = 1.f;
#pragma unroll
        for (int ap = 0; ap < 4; ++ap) if (ap >= sa) {
            if (ap > sa) m *= (ap == 1 ? tt0 : (ap == 2 ? tt1 : tt2));
            *(LAS bf16*)(lds + IM_KB + img256(16 * (ap * (ap + 1) / 2 + sa) + r, chk) + cb2) = f2bf1(ik * m); }
    }
    MIX_BAR();
    bf16x8 qa4[4];
#pragma unroll
    for (int ks = 0; ks < 4; ++ks) qa4[ks] = *(const LAS bf16x8*)(lds + IM_QA + img256(16 * ia + fr, 4 * ks + g));
#pragma unroll
    for (int jj = 0; jj < 2; ++jj) { const int jb = cc0 + jj; v2u pw = (v2u){0u, 0u};
        if (jb <= ia) {
            f32x4 sc = (f32x4){0.f, 0.f, 0.f, 0.f};
            const unsigned kbrow = 16u * (ia * (ia + 1) / 2 + jb);
#pragma unroll
            for (int ks = 0; ks < 4; ++ks) { const bf16x8 kf = *(const LAS bf16x8*)(lds + IM_KB + img256(kbrow + fr, 4 * ks + g)); sc = __builtin_amdgcn_mfma_f32_16x16x32_bf16(kf, qa4[ks], sc, 0, 0, 0); }
            if (jb == ia) {
#pragma unroll
                for (int r = 0; r < 4; ++r) sc[r] = (4 * g + r <= fr) ? sc[r] : 0.f; }
            pw.x = pk2(sc[0], sc[1]); pw.y = pk2(sc[2], sc[3]);
        }
        *(LAS v2u*)(lds + IM_P + imgP(16 * ia + fr, 2 * jb + (g >> 1)) + 8 * (g & 1)) = pw;
    }
    MIX_BAR();
    unsigned char* rec = F.ws + WS_HP + ((size_t)(b * 4 + h) * 32 + n) * HPU;
#pragma unroll
    for (int j = 0; j < 5; ++j) { const int p = tid + 512 * j; *(v4u*)(rec + (size_t)p * 16) = *(const LAS v4u*)(lds + IM_HCOPY(p)); }
    if (tid < 32) *(f32x4*)(rec + 40960 + tid * 16) = *(const LAS f32x4*)(lastv + 4 * tid);
    MIX_BAR();
}

__device__ __forceinline__ void phase_ssd_dt(Frame& F, const Args& A, int l) {
    const float* DT = (const float*)(F.ws + WS_DT); f32x4* SD = (f32x4*)(F.ws + WS_SD);
    const int gw = F.bid * NWAVES + F.wave, NGW = F.G * NWAVES, lane = F.lane;
    for (int it = gw; it < 8 * 16 * (SEQ / 64); it += NGW) { const int n = it & 31, h = (it >> 5) & 15, b = it >> 9;
        const float dtb = A.in[I_DTB][l * 16 + h], Aneg = -__expf(A.in[I_ALOG][l * 16 + h]);
        const float xdt = DT[((size_t)b * SEQ + n * 64 + lane) * 16 + h] + dtb;
        const float dt = xdt > 20.f ? xdt : log1pf(__expf(xdt));
        float cum = dt * Aneg;
#pragma unroll
        for (int o = 1; o < 64; o <<= 1) { const float tmp = __shfl_up(cum, o); if (lane >= o) cum += tmp; }
        const float wl = __expf(__shfl(cum, 63) - cum);
        SD[((size_t)(b * 16 + h)) * SEQ + n * 64 + lane] = (f32x4){dt, cum, wl, __expf(cum)}; }
}
template <int TYPE>
__device__ __forceinline__ void mix_stream(Frame& F, const Args& A, int l, int b, int h, int half) {
    LAS unsigned char* lds = F.lds;
    const bf16* P = (const bf16*)(F.ws + WS_P); bf16* MO = (bf16*)(F.ws + WS_U);
    LAS float* cumv = (LAS float*)(lds + SM_CUM); LAS float* totv = (LAS float*)(lds + SM_TOT); LAS float* lastv = (LAS float*)(lds + SM_LAST);
    const int tid = F.tid, w = F.wave, lane = F.lane;
    const int ia = w >> 1, cc0 = (w & 1) * 2;
    const int ocol = TYPE == MX_RET ? h * 128 + half * 64 : (TYPE == MX_SSD ? 512 + h * 64 : 1536 + h * 128 + half * 64);
    f32x4 S[4];
#pragma unroll
    for (int c = 0; c < 4; ++c) S[c] = (f32x4){0.f, 0.f, 0.f, 0.f};
    for (int i = tid; i < 1024; i += NWAVES * 64) ((LAS v4u*)(lds + IM_ST))[i] = (v4u){0u, 0u, 0u, 0u};
    const int pt = tid >> 3, pib = tid & 7;
    float vs_scale = 1.f;
    float dtb = 0.f, Aneg = 0.f, dsk = 0.f;
    if constexpr (TYPE == MX_RET) {
        const float lg2 = log2f(1.f - exp2f(-5.f - (float)h));
        vs_scale = exp2f((float)(63 - pt) * lg2);
        if (tid < 64) cumv[tid] = (float)(tid + 1) * lg2 * 0.6931471805599453f;
    }
    if constexpr (TYPE == MX_SSD) {
        dtb = A.in[I_DTB][l * 16 + h]; Aneg = -__expf(A.in[I_ALOG][l * 16 + h]); dsk = A.in[I_SSDD][l * 16 + h];
    }
    const float* cosT = (const float*)(F.ws + WS_ROT); const float* sinT = (const float*)(F.ws + WS_ROT + SZ_ROT);
    v4u rq0, rq1, rk0, rk1, rv; f32x4 rc0, rc1, rs0, rs1;
    f32x4 rsd = (f32x4){0.f, 0.f, 0.f, 0.f};
    v4u hp[5]; f32x4 hlv = (f32x4){0.f, 0.f, 0.f, 0.f};
#define MIX_LOAD(nn) do { const int t0n = (nn) * 64; const size_t row0n = (size_t)b * SEQ + t0n; \
        if constexpr (TYPE == MX_RET) { const size_t pr_ = row0n + pt; \
            rq0 = *(const v4u*)(P + PB(pr_, C_RQ + h * 128 + 8 * pib)); rq1 = *(const v4u*)(P + PB(pr_, C_RQ + h * 128 + 64 + 8 * pib)); \
            rk0 = *(const v4u*)(P + PB(pr_, C_RK + h * 128 + 8 * pib)); rk1 = *(const v4u*)(P + PB(pr_, C_RK + h * 128 + 64 + 8 * pib)); \
            rv = *(const v4u*)(P + PB(pr_, C_RV + h * 128 + half * 64 + 8 * pib)); \
            const f32x4* cp = (const f32x4*)(cosT + (size_t)(t0n + pt) * 64 + 8 * pib); const f32x4* sp = (const f32x4*)(sinT + (size_t)(t0n + pt) * 64 + 8 * pib); \
            rc0 = cp[0]; rc1 = cp[1]; rs0 = sp[0]; rs1 = sp[1]; } \
        if constexpr (TYPE == MX_SSD) { rsd = ((const f32x4*)(F.ws + WS_SD))[(size_t)(b * 16 + h) * SEQ + t0n + lane]; \
            const bf16* xc = (const bf16*)(F.ws + WS_XC) + (row0n + pt) * CONVD; const int grp_ = h >> 3; \
            rq0 = *(const v4u*)(xc + 1280 + grp_ * 128 + 8 * pib); rq1 = *(const v4u*)(xc + 1280 + grp_ * 128 + 64 + 8 * pib); \
            rk0 = *(const v4u*)(xc + 1024 + grp_ * 128 + 8 * pib); rk1 = *(const v4u*)(xc + 1024 + grp_ * 128 + 64 + 8 * pib); \
            rv = *(const v4u*)(xc + h * 64 + 8 * pib); } \
        if constexpr (TYPE == MX_HGRN) { const unsigned char* rec = F.ws + WS_HP + ((size_t)(b * 4 + h) * 32 + (nn)) * HPU; \
            _Pragma("unroll") for (int j = 0; j < 5; ++j) hp[j] = *(const v4u*)(rec + (size_t)(tid + 512 * j) * 16); \
            if (tid < 32) hlv = *(const f32x4*)(rec + 40960 + tid * 16); \
            rv = *(const v4u*)(P + PB(row0n + pt, C_HI + h * 128 + half * 64 + 8 * pib)); } \
    } while (0)
    MIX_LOAD(0);
    MIX_BAR();

    for (int n = 0; n < SEQ / 64; ++n) {
        const int t0 = n * 64; const size_t row0 = (size_t)b * SEQ + t0;
        int lz = lane; asm volatile("" : "+v"(lz));
        const int fr = lz & 15, g = lz >> 4, q4 = fr >> 2, p4 = fr & 3;
        bf16 zr[2][4];
        if constexpr (TYPE == MX_SSD) {
#pragma unroll
            for (int cc = 0; cc < 2; ++cc)
#pragma unroll
                for (int r = 0; r < 4; ++r) zr[cc][r] = P[PB(row0 + 16 * ia + 4 * g + r, C_SZ + h * 64 + 16 * (cc0 + cc) + fr)];
        }
        if constexpr (TYPE == MX_RET) {
            float ql[8], qh[8], kl[8], kh[8], vv[8], cs[8], sn[8], o0[8], o1[8];
            unpack8(rq0, ql); unpack8(rq1, qh); unpack8(rk0, kl); unpack8(rk1, kh); unpack8(rv, vv);
#pragma unroll
            for (int e = 0; e < 4; ++e) { cs[e] = rc0[e]; cs[4 + e] = rc1[e]; sn[e] = rs0[e]; sn[4 + e] = rs1[e]; }
#pragma unroll
            for (int e = 0; e < 8; ++e) { o0[e] = ql[e] * cs[e] - qh[e] * sn[e]; o1[e] = ql[e] * sn[e] + qh[e] * cs[e]; }
            *(LAS v4u*)(lds + IM_QA + img256(pt, pib)) = pack8(o0); *(LAS v4u*)(lds + IM_QA + img256(pt, 8 + pib)) = pack8(o1);
#pragma unroll
            for (int e = 0; e < 8; ++e) { o0[e] = (kl[e] * cs[e] - kh[e] * sn[e]) * 0.08838834764831845f; o1[e] = (kl[e] * sn[e] + kh[e] * cs[e]) * 0.08838834764831845f; }
            *(LAS v4u*)(lds + IM_KB + img256(pt, pib)) = pack8(o0); *(LAS v4u*)(lds + IM_KB + img256(pt, 8 + pib)) = pack8(o1);
            *(LAS v4u*)(lds + IM_V + imgV(pt, pib)) = pack8(vv);
#pragma unroll
            for (int e = 0; e < 8; ++e) vv[e] *= vs_scale;
            *(LAS v4u*)(lds + IM_VS + imgV(pt, pib)) = pack8(vv);
        }
        if constexpr (TYPE == MX_SSD) {
            if (w == 0) { cumv[lane] = rsd[1]; cumv[64 + lane] = rsd[3]; }
            const float sdt = __shfl(rsd[0], pt), swl = __shfl(rsd[2], pt);
            float kl[8], kh[8], vv[8];
            unpack8(rk0, kl); unpack8(rk1, kh); unpack8(rv, vv);
            *(LAS v4u*)(lds + IM_QA + img256(pt, pib)) = rq0; *(LAS v4u*)(lds + IM_QA + img256(pt, 8 + pib)) = rq1;
#pragma unroll
            for (int e = 0; e < 8; ++e) { kl[e] *= sdt; kh[e] *= sdt; }
            *(LAS v4u*)(lds + IM_KB + img256(pt, pib)) = pack8(kl); *(LAS v4u*)(lds + IM_KB + img256(pt, 8 + pib)) = pack8(kh);
            *(LAS v4u*)(lds + IM_V + imgV(pt, pib)) = rv;
#pragma unroll
            for (int e = 0; e < 8; ++e) vv[e] *= swl;
            *(LAS v4u*)(lds + IM_VS + imgV(pt, pib)) = pack8(vv);
        }
        if constexpr (TYPE == MX_HGRN) {
#pragma unroll
            for (int j = 0; j < 5; ++j) *(LAS v4u*)(lds + IM_HCOPY(tid + 512 * j)) = hp[j];
            *(LAS v4u*)(lds + IM_V + imgV(pt, pib)) = rv;
            if (tid < 32) *(LAS f32x4*)(lastv + 4 * tid) = hlv;
        }
        { const int nn = n + 1 < SEQ / 64 ? n + 1 : n; MIX_LOAD(nn); }
        MIX_BAR();
        bf16x8 qa[4];
#pragma unroll
        for (int ks = 0; ks < 4; ++ks) qa[ks] = *(const LAS bf16x8*)(lds + IM_QA + img256(16 * ia + fr, 4 * ks + g));
#pragma unroll
        for (int jj = 0; jj < 2; ++jj) if (TYPE != MX_HGRN) { const int jb = cc0 + jj; v2u pw = (v2u){0u, 0u};
            if (jb <= ia) {
                f32x4 sc = (f32x4){0.f, 0.f, 0.f, 0.f};
                const unsigned kbrow = TYPE == MX_HGRN ? 16u * (ia * (ia + 1) / 2 + jb) : 16u * jb;
#pragma unroll
                for (int ks = 0; ks < 4; ++ks) { const bf16x8 kf = *(const LAS bf16x8*)(lds + IM_KB + img256(kbrow + fr, 4 * ks + g)); sc = __builtin_amdgcn_mfma_f32_16x16x32_bf16(kf, qa[ks], sc, 0, 0, 0); }
                if constexpr (TYPE != MX_HGRN) { const float ci = cumv[16 * ia + fr]; const f32x4 cj = *(const LAS f32x4*)(cumv + 16 * jb + 4 * g);
#pragma unroll
                    for (int r = 0; r < 4; ++r) sc[r] *= __expf(fminf(ci - cj[r], 0.f)); }
                if (jb == ia) {
#pragma unroll
                    for (int r = 0; r < 4; ++r) sc[r] = (4 * g + r <= fr) ? sc[r] : 0.f; }
                pw.x = pk2(sc[0], sc[1]); pw.y = pk2(sc[2], sc[3]);
            }
            *(LAS v2u*)(lds + IM_P + imgP(16 * ia + fr, 2 * jb + (g >> 1)) + 8 * (g & 1)) = pw;
        }
        f32x4 qs[2];
        {
            bf16x8 qb[4];
            if constexpr (TYPE == MX_HGRN) {
#pragma unroll
                for (int ks = 0; ks < 4; ++ks) qb[ks] = *(const LAS bf16x8*)(lds + IM_QB + img256(16 * ia + fr, 4 * ks + g));
            } else {
#pragma unroll
                for (int ks = 0; ks < 4; ++ks) qb[ks] = qa[ks];
            }
#pragma unroll
            for (int cc = 0; cc < 2; ++cc) { qs[cc] = (f32x4){0.f, 0.f, 0.f, 0.f};
#pragma unroll
                for (int ks = 0; ks < 4; ++ks) { const bf16x8 sf = *(const LAS bf16x8*)(lds + IM_ST + img256(16 * (cc0 + cc) + fr, 4 * ks + g)); qs[cc] = __builtin_amdgcn_mfma_f32_16x16x32_bf16(qb[ks], sf, qs[cc], 0, 0, 0); } }
        }
        MIX_BAR();
        {
            const unsigned tra0 = (unsigned)(8 * g + q4), trc = (unsigned)(p4 >> 1), trb = 8u * (unsigned)(p4 & 1);
#pragma unroll
            for (int cc = 0; cc < 2; ++cc) { const int c = cc0 + cc; f32x4 pv = (f32x4){0.f, 0.f, 0.f, 0.f};
#pragma unroll
                for (int ks = 0; ks < 2; ++ks) if (ks == 0 || ia >= 2) {
                    const bf16x8 pf = *(const LAS bf16x8*)(lds + IM_P + imgP(16 * ia + fr, 4 * ks + g));
                    const bf16x8 vf = tr_pair(lds + IM_V, imgV(32 * ks + tra0, 2 * c + trc) + trb, imgV(32 * ks + tra0 + 4, 2 * c + trc) + trb);
                    pv = __builtin_amdgcn_mfma_f32_16x16x32_bf16(pf, vf, pv, 0, 0, 0); }
#pragma unroll
                for (int r = 0; r < 4; ++r) { const int i = 16 * ia + 4 * g + r, v = 16 * c + fr; float o;
                    if constexpr (TYPE == MX_HGRN) o = pv[r] + qs[cc][r]; else if constexpr (TYPE == MX_SSD) o = pv[r] + cumv[64 + i] * qs[cc][r]; else o = pv[r] + __expf(cumv[i]) * qs[cc][r];
                    if constexpr (TYPE == MX_SSD) { const float xv = bf2f(*(const LAS bf16*)(lds + IM_V + imgV(i, v >> 3) + (v & 7) * 2)); o = (o + dsk * xv) * siluf(bf2f(zr[cc][r])); }
                    MO[(row0 + i) * DM + ocol + v] = f2bf1(o); }
            }
            if constexpr (TYPE == MX_HGRN) { const f32x4 d = *(const LAS f32x4*)(lastv + 16 * w + 4 * g);
#pragma unroll
                for (int c = 0; c < 4; ++c) S[c] = S[c] * d; }
            else { const float d = TYPE == MX_SSD ? cumv[64 + 63] : __expf(cumv[63]);
#pragma unroll
                for (int c = 0; c < 4; ++c) S[c] = S[c] * d; }
            constexpr int IMK = TYPE == MX_HGRN ? IM_KS : IM_KB, IMV2 = TYPE == MX_HGRN ? IM_V : IM_VS;
#pragma unroll
            for (int ks = 0; ks < 2; ++ks) {
                const bf16x8 af = tr_pair(lds + IMK, img256(32 * ks + tra0, 2 * w + trc) + trb, img256(32 * ks + tra0 + 4, 2 * w + trc) + trb);
#pragma unroll
                for (int c = 0; c < 4; ++c) { const bf16x8 bv = tr_pair(lds + IMV2, imgV(32 * ks + tra0, 2 * c + trc) + trb, imgV(32 * ks + tra0 + 4, 2 * c + trc) + trb);
                    S[c] = __builtin_amdgcn_mfma_f32_16x16x32_bf16(af, bv, S[c], 0, 0, 0); } }
        }
        MIX_BAR();
#pragma unroll
        for (int c = 0; c < 4; ++c) { v2u sw; sw.x = pk2(S[c][0], S[c][1]); sw.y = pk2(S[c][2], S[c][3]);
            *(LAS v2u*)(lds + IM_ST + img256(16 * c + fr, 2 * w + (g >> 1)) + 8 * (g & 1)) = sw; }
    }
    VM_WAIT(); MIX_BAR();
#undef MIX_LOAD
}

__device__ __forceinline__ void phase_mix(Frame& F, const Args& A, int l) {
    { const int s = F.bid;
        if (s < 64) { { const int x = s & 7, j = s >> 3, pr = (j >> 1) * 8 + x; mix_stream<MX_RET>(F, A, l, pr >> 2, pr & 3, j & 1); }     }
        else if (s < 192) { const int sb = s - 64; { const int x = sb & 7, j = sb >> 3, pg = (j >> 3) * 8 + x; mix_stream<MX_SSD>(F, A, l, pg >> 1, (pg & 1) * 8 + (j & 7), 0); }     }
        else { const int sb = s - 192; { const int x = sb & 7, j = sb >> 3, pr = (j >> 1) * 8 + x; mix_stream<MX_HGRN>(F, A, l, pr >> 2, pr & 3, j & 1); } }
    }
}

__device__ __forceinline__ void phase_ssdnorm(Frame& F, const Args& A, int l) {
    bf16* MO = (bf16*)(F.ws + WS_U); const bf16* P = (const bf16*)(F.ws + WS_P);
    const int gw = F.bid * NWAVES + F.wave, NGW = F.G * NWAVES, lane = F.lane;
    const int kind = lane < 16 ? 0 : (lane < 48 ? 1 : 2);
    float wq[32];
    { const float* wp = kind == 1 ? A.in[I_SSDNW] + l * 1024 + 32 * (lane - 16) : A.in[I_HNW] + l * 512 + 32 * ((lane - 48) & 15);
#pragma unroll
        for (int j = 0; j < 32; ++j) wq[j] = kind != 0 ? wp[j] : 1.f; }
    for (int row = gw; row < NTOK; row += 2 * NGW) {
        v4u xin[2][4], gin[2][4];
#pragma unroll
        for (int q = 0; q < 2; ++q) { const size_t rw = (size_t)row + (size_t)q * NGW;
            const v4u* p = (const v4u*)(MO + rw * DM + 32 * lane);
            const v4u* gp = (const v4u*)(P + PB(rw, kind == 0 ? C_RG + 32 * lane : C_HG + 32 * ((lane - 48) & 15)));
#pragma unroll
            for (int c = 0; c < 4; ++c) { xin[q][c] = p[c]; gin[q][c] = kind != 1 ? gp[c] : (v4u){0u, 0u, 0u, 0u}; } }
#pragma unroll
        for (int q = 0; q < 2; ++q) { const size_t rw = (size_t)row + (size_t)q * NGW;
            float f[32];
#pragma unroll
            for (int c = 0; c < 4; ++c) { float t8[8]; unpack8(xin[q][c], t8);
#pragma unroll
                for (int j = 0; j < 8; ++j) f[8 * c + j] = t8[j]; }
            float ss = 0.f;
#pragma unroll
            for (int j = 0; j < 32; ++j) ss += f[j] * f[j];
            ss += __shfl_xor(ss, 1); ss += __shfl_xor(ss, 2);
            float s16 = ss; s16 += __shfl_xor(s16, 4); s16 += __shfl_xor(s16, 8);
            const float rstd = 1.f / sqrtf((kind == 1 ? s16 * (1.f / 512.f) : ss * (1.f / 128.f)) + EPS);
            v4u* po = (v4u*)(MO + rw * DM + 32 * lane);
#pragma unroll
            for (int c = 0; c < 4; ++c) { float o[8], gg[8]; unpack8(gin[q][c], gg);
#pragma unroll
                for (int j = 0; j < 8; ++j) { float v = f[8 * c + j] * rstd * wq[8 * c + j]; if (kind != 1) v *= siluf(gg[j]); o[j] = v; }
                po[c] = pack8(o); }
        }
    }
}

__device__ __forceinline__ void phase_final(Frame& F, const Args& A) {
    const bf16* Y = (const bf16*)(F.ws + WS_Y); const int* slot = (const int*)(F.ws + WS_SLOT);
    build_tables(F, NLAYER - 1);
    const int gw = F.bid * NWAVES + F.wave, NGW = F.G * NWAVES;
    f32x4 wv[8]; load_normw(A.in[I_FINW], wv, F.lane);
    for (int row = gw; row < NTOK; row += 2 * NGW) {
        const float* src[2]; float* hd[2] = {nullptr, nullptr}; const bf16* ya[2]; const bf16* yb[2]; bf16* ud[2] = {nullptr, nullptr}; float* fd[2];
#pragma unroll
        for (int q = 0; q < 2; ++q) { const int rw = row + q * NGW; const int s0 = slot[rw * 2], s1 = slot[rw * 2 + 1];
            ya[q] = Y + ((size_t)F.tab[T_EBASE + (s0 >> 16)] * 256 + (s0 & 0xffff)) * (MOE_FP8 ? DM / 2 : DM); yb[q] = Y + ((size_t)F.tab[T_EBASE + (s1 >> 16)] * 256 + (s1 & 0xffff)) * (MOE_FP8 ? DM / 2 : DM);
            src[q] = H_BF16 ? (const float*)((const bf16*)(F.ws + WS_H) + (size_t)rw * DM) : F.out + (size_t)rw * DM; fd[q] = F.out + (size_t)rw * DM; }
        norm_rows<2, 2, false, H_BF16>(src, hd, ya, yb, wv, ud, fd, F.lane); }
}

constexpr int NPH = 8, GP_TOTAL = 2 + NLAYER * NPH;
__global__ void __launch_bounds__(NWAVES * 64, 2) mk_fwd(Args args) {
    extern __shared__ __attribute__((aligned(16))) unsigned char lds[];
    Frame F;
    F.lds = (LAS unsigned char*)lds;
    F.MISC = (volatile LAS unsigned*)(F.lds + MISC_OFF);
    F.tab = (LAS int*)(F.lds + TAB_OFF);
    F.tid = threadIdx.x; F.lane = F.tid & 63; F.wave = __builtin_amdgcn_readfirstlane(F.tid >> 6);
    F.G = gridDim.x; F.bid = blockIdx.x;
    F.out = args.out; F.ws = args.ws; F.ctl = (unsigned*)(args.ws + WS_CTL);
    for (int u = F.tid; u < (LDS_BYTES - LDSCTL_OFF) / 4; u += NWAVES * 64) ((LAS unsigned*)(F.lds + LDSCTL_OFF))[u] = 0u;
    __syncthreads();
    const int lo = args.gp_lo, hi = args.gp_hi;
    XcdBarrier bar; bar.bar = F.ctl + CW_BAR; bar.x = 0; bar.st = nullptr;
    if (hi - lo > 1) bar = xcd_barrier_post(F.ctl + CW_BAR, F.MISC + 8);
#define IN(k) (lo <= (k) && (k) < hi)
#define SEAM(k) do { if ((k) + 1 < hi) xcd_barrier(bar); } while (0)

    if (IN(0)) { phase_prologue(F, args); SEAM(0); }
#define LAYER_BODY(l, pb) \
        if (IN(pb + 0)) { phase_norm1(F, args, l); SEAM(pb + 0); } \
        if (IN(pb + 1)) { \
            pg8::Gemm g{(const bf16*)(F.ws + WS_U), (const bf16*)(F.ws + WS_WIN + l * SZ_WIN), NTOK, NP, DM, 0u}; pg8::StaticOrder S; \
            pg8::EpiBf16Blk E{(bf16*)(F.ws + WS_P), NTOK}; \
            if (l == 0) { if (F.bid < G1_WGS) { S.init(NTOK, NP, G1_WGS, F.bid); pg8::gemm_phase<pg8::EpiBf16Blk, pg8::StaticOrder, true>(F.lds, g, S, E); } \
                          else convert_items(F, args, CONV_SPLIT, CT_LO, (F.bid - G1_WGS) * NWAVES + F.wave, (F.G - G1_WGS) * NWAVES); } \
            else { S.init(NTOK, NP, F.G, F.bid); pg8::gemm_phase<pg8::EpiBf16Blk, pg8::StaticOrder, true>(F.lds, g, S, E); \
                   if (F.bid >= 128) convert_items(F, args, CT_LO, NLAYER * TI_LAYER, (F.bid - 128) * NWAVES + F.wave, 128 * NWAVES); } \
            SEAM(pb + 1); \
        } \
        if (IN(pb + 2)) { phase_ssd_dt(F, args, l); phase_conv(F, args, l); for (int u = F.bid; u < 1024; u += F.G) hgrn_prep_unit(F, args, l, u >> 7, (u >> 5) & 3, u & 31); xcd_barrier(bar); phase_mix(F, args, l); SEAM(pb + 2); } \
        if (IN(pb + 3)) { phase_ssdnorm(F, args, l); SEAM(pb + 3); } \
        if (IN(pb + 4)) { \
            pg8::Gemm g{(const bf16*)(F.ws + WS_U), (const bf16*)(F.ws + WS_WOUT + l * SZ_WOUT), NTOK, DM, DM, 0u}; pg8::StaticOrder S; S.init(NTOK, DM, F.G, F.bid); \
            if (H_BF16) { if (l == 0) { pg8::EpiResH<true> E{args.in[I_X], (bf16*)(F.ws + WS_H), DM}; pg8::gemm_phase<pg8::EpiResH<true>, pg8::StaticOrder, true>(F.lds, g, S, E); } \
                          else { pg8::EpiResH<false> E{(const void*)(F.ws + WS_H), (bf16*)(F.ws + WS_H), DM}; pg8::gemm_phase<pg8::EpiResH<false>, pg8::StaticOrder, true>(F.lds, g, S, E); } } \
            else { pg8::EpiResF32 E{l == 0 ? args.in[I_X] : F.out, F.out, DM}; pg8::gemm_phase<pg8::EpiResF32, pg8::StaticOrder, false>(F.lds, g, S, E); } \
            SEAM(pb + 4); \
        } \
        if (IN(pb + 5)) { phase_norm2(F, args, l); SEAM(pb + 5); } \
        if (IN(pb + 6)) { \
            build_tables(F, l); \
            const int ntiles = (int)F.MISC[16]; \
            const int* tokl = (const int*)(F.ws + WS_TOK); \
            for (int i = 0; i < 4; ++i) { const int L = i * F.G + F.bid; if (L < ntiles * 4) { const int v = F.tab[T_TMAP + L / 4], e = v >> 8, lt = v & 255, cnt = F.tab[T_ECNT + e]; \
                for (int r = F.tid; r < 256; r += NWAVES * 64) { const int lr = lt * 256 + r; F.tab[T_GTAB + i * 256 + r] = tokl[(size_t)e * NTOK + (lr < cnt ? lr : 0)]; } } } \
            __syncthreads(); \
            pg8::MoeOrder<true> S{F.tab + T_TMAP, F.tab + T_GTAB, ntiles, 4, F.G, F.bid, SZ_WGU1}; \
            if (MOE_FP8) { pg8::Gemm g{(const bf16*)(F.ws + WS_U8), (const bf16*)(F.ws + WS_WGU + (size_t)l * NEXP * SZ_WGU1), PADROWS, 1024, DM / 2, 0x79797979u}; \
                pg8::EpiSwiGlu8 E{F.ws + WS_HID}; pg8::gemm_phase<pg8::EpiSwiGlu8, pg8::MoeOrder<true>, true, true>(F.lds, g, S, E); } \
            else { pg8::Gemm g{(const bf16*)(F.ws + WS_U), (const bf16*)(F.ws + WS_WGU + (size_t)l * NEXP * SZ_WGU1), PADROWS, 1024, DM, 0u}; \
                pg8::EpiSwiGlu E{(bf16*)(F.ws + WS_HID)}; pg8::gemm_phase<pg8::EpiSwiGlu, pg8::MoeOrder<true>, true>(F.lds, g, S, E); } \
            SEAM(pb + 6); \
        } \
        if (IN(pb + 7)) { \
            build_tables(F, l); \
            const int ntiles = (int)F.MISC[16]; \
            pg8::MoeOrder<false> S{F.tab + T_TMAP, F.tab + T_GTAB, ntiles, 8, F.G, F.bid, SZ_WD1}; \
            pg8::EpiScaleBf16 E{(bf16*)(F.ws + WS_Y), DM, (const float*)(F.ws + WS_WT), F.tab + T_ECNT}; \
            if (MOE_FP8) { pg8::Gemm g{(const bf16*)(F.ws + WS_HID), (const bf16*)(F.ws + WS_WD + (size_t)l * NEXP * SZ_WD1), PADROWS, DM, DEXP / 2, 0x7a7a7a7au}; \
                pg8::EpiScaleF8 E8{F.ws + WS_Y, DM, (const float*)(F.ws + WS_WT), F.tab + T_ECNT}; \
                pg8::gemm_phase<pg8::EpiScaleF8, pg8::MoeOrder<false>, true, true>(F.lds, g, S, E8); } \
            else { pg8::Gemm g{(const bf16*)(F.ws + WS_HID), (const bf16*)(F.ws + WS_WD + (size_t)l * NEXP * SZ_WD1), PADROWS, DM, DEXP, 0u}; \
                pg8::gemm_phase<pg8::EpiScaleBf16, pg8::MoeOrder<false>, true>(F.lds, g, S, E); } \
            SEAM(pb + 7); \
        }
    { constexpr int l = 0, pb = 1; LAYER_BODY(l, pb) }
    { constexpr int l = 1, pb = 1 + NPH; LAYER_BODY(l, pb) }
#undef LAYER_BODY
    if (IN(GP_TOTAL - 1)) phase_final(F, args);
#undef IN
#undef SEAM
}

extern "C" void kernel_launch(void* const* d_in, const int* in_sizes, int n_in, void* d_out, int out_size, void* d_ws, size_t ws_size, hipStream_t stream) {
    static int grid = 0;
    if (grid == 0) {
        if (n_in != 21 || out_size != NTOK * DM || ws_size < WS_END) { fprintf(stderr, "kernel_launch: unexpected shapes (n_in %d, out %d, ws %zu, need %zu)\n", n_in, out_size, ws_size, (size_t)WS_END); grid = -1; return; }
        int dev = 0, cus = 0, per_cu = 0;
        if (hipGetDevice(&dev) != hipSuccess || hipDeviceGetAttribute(&cus, hipDeviceAttributeMultiprocessorCount, dev) != hipSuccess) { grid = -1; return; }
        if (hipFuncSetAttribute((const void*)mk_fwd, hipFuncAttributeMaxDynamicSharedMemorySize, LDS_BYTES) != hipSuccess) { fprintf(stderr, "kernel_launch: hipFuncSetAttribute failed\n"); grid = -1; return; }
        if (hipOccupancyMaxActiveBlocksPerMultiprocessor(&per_cu, (const void*)mk_fwd, NWAVES * 64, LDS_BYTES) != hipSuccess || per_cu < 1) fprintf(stderr, "kernel_launch: occupancy query reports %d\n", per_cu);
        (void)hipGetLastError();
        grid = cus;
        if (grid != 256) { fprintf(stderr, "kernel_launch: built for a 256-CU device (got %d)\n", cus); grid = -1; return; }
    }
    if (grid < 0) return;
    if (hipMemsetAsync((char*)d_ws + WS_CTL, 0, CTL_ZERO_BYTES, stream) != hipSuccess) return;
    Args a{};
    for (int i = 0; i < 21; ++i) a.in[i] = (const float*)d_in[i];
    a.out = (float*)d_out; a.ws = (unsigned char*)d_ws;
#if MK_LAUNCH_PER_PHASE
    for (int p = 0; p < GP_TOTAL; ++p) { a.gp_lo = p; a.gp_hi = p + 1; hipLaunchKernelGGL(mk_fwd, dim3(grid), dim3(NWAVES * 64), LDS_BYTES, stream, a); }
#else
    a.gp_lo = 0; a.gp_hi = GP_TOTAL;
    hipLaunchKernelGGL(mk_fwd, dim3(grid), dim3(NWAVES * 64), LDS_BYTES, stream, a);
#endif
    const hipError_t le = hipPeekAtLastError();
    if (le != hipSuccess) fprintf(stderr, "kernel_launch: launch failed: %s\n", hipGetErrorName(le));
}
```

```cpp
#include <hip/hip_runtime.h>
#include <cstdio>
#include <cstdint>

#ifndef MOE_FP8
#define MOE_FP8 1
#endif
#ifndef H_BF16
#define H_BF16 1
#endif
#ifndef MK_LAUNCH_PER_PHASE
#define MK_LAUNCH_PER_PHASE 0
#endif

#define LAS __attribute__((address_space(3)))
#define GAS __attribute__((address_space(1)))
typedef unsigned short bf16;
typedef unsigned v4u __attribute__((ext_vector_type(4)));
typedef unsigned v2u __attribute__((ext_vector_type(2)));
typedef float f32x4 __attribute__((ext_vector_type(4)));
typedef float f32x2 __attribute__((ext_vector_type(2)));
typedef short bf16x8 __attribute__((ext_vector_type(8)));
typedef GAS unsigned gu32;
#define RLX_AGENT __ATOMIC_RELAXED, __HIP_MEMORY_SCOPE_AGENT
#define LDS_WAIT() asm volatile("s_waitcnt lgkmcnt(0)" ::: "memory")
#define VM_WAIT() asm volatile("s_waitcnt vmcnt(0)" ::: "memory")

constexpr int DM = 2048, NTOK = 16384, SEQ = 2048, NLAYER = 2;
constexpr int IN_DIM = 6672, NP = 6656;
constexpr int C_RQ = 0, C_RK = 512, C_RV = 1024, C_RG = 1536, C_SZ = 2048, C_SX = 3072, C_SB = 4096, C_SC = 4352, C_HQ = 4608, C_HF = 5120, C_HI = 5632, C_HG = 6144;
constexpr int DT_COL0 = 4608;
constexpr int NEXP = 32, DEXP = 512, CONVD = 1536;
constexpr int MAXTILES = 161, PADROWS = MAXTILES * 256;
constexpr float EPS = 1e-6f;

__host__ __device__ __forceinline__ size_t PB(size_t row, int col) { return ((size_t)(col >> 7) * NTOK + row) * 128 + (col & 127); }
__device__ __forceinline__ float bf2f(bf16 x) { return __uint_as_float(((unsigned)x) << 16); }
__device__ __forceinline__ unsigned f2bf(float f) { unsigned u = __float_as_uint(f); return (u + 0x7fffu + ((u >> 16) & 1u)) >> 16; }
typedef __bf16 bf16x2v __attribute__((ext_vector_type(2)));
__device__ __forceinline__ unsigned pk2(float lo, float hi) { const f32x2 v = {lo, hi}; return __builtin_bit_cast(unsigned, __builtin_convertvector(v, bf16x2v)); }
__device__ __forceinline__ bf16 f2bf1(float f) { return (bf16)pk2(f, f); }
__device__ __forceinline__ float siluf(float x) { return x * __builtin_amdgcn_rcpf(1.f + __expf(-x)); }
__device__ __forceinline__ float sigmf(float x) { return __builtin_amdgcn_rcpf(1.f + __expf(-x)); }
__device__ __forceinline__ float wave_sum(float v) {
#pragma unroll
    for (int o = 1; o < 64; o <<= 1) v += __shfl_xor(v, o);
    return v;
}

#define cvt2_fp8(a, b, old, hi) __builtin_amdgcn_cvt_pk_fp8_f32(__builtin_amdgcn_fmed3f((a), -448.f, 448.f), __builtin_amdgcn_fmed3f((b), -448.f, 448.f), (old), (hi))
namespace pg8 {
constexpr int BM = 256, BK = 64, HALF = 128, HTB = HALF * BK * 2, STAGE_BYTES = 8 * HTB, NXCD = 8, WGM = 8;
__host__ __device__ __forceinline__ int lds_byte(int r, int c) { const int st = (r >> 4) * 2 + (c >> 5), rr = r & 15, cc = c & 31, ob = rr * 64 + cc * 2; return st * 1024 + (ob ^ (((ob >> 9) & 1) << 5)); }
__host__ __device__ __forceinline__ void stage_rc(int b, int& R, int& C) { const int st = b / 1024, sb = b % 1024, swz = sb ^ (((sb >> 9) & 1) << 5); R = (st >> 1) * 16 + swz / 64; C = (st & 1) * 32 + (swz % 64) / 2; }
__host__ __device__ __forceinline__ int perm32(int rho) { const int n = rho >> 4, i = rho & 15; return 8 * (i >> 2) + 4 * n + (i & 3); }

struct Unit { int pm, pn, e, lt; };
struct Gemm { const bf16* A; const bf16* Bt; int M, N, K; unsigned wscale; };

struct StaticOrder {
    static constexpr bool GATHER = false;
    int nM, nN, nwg, G, c;
    __device__ void init(int M, int N, int G_, int c_) { nM = M / BM; nN = N / BM; nwg = nM * nN; G = G_; c = c_; }
    __device__ bool next(int i, Unit& u) const {
        const long L = (long)i * G + c; if (L >= nwg) return false;
        int wgid = (int)L; { const int q = nwg / NXCD, r = nwg % NXCD, xcd = wgid % NXCD, off = wgid / NXCD; wgid = (xcd < r ? xcd * (q + 1) : r * (q + 1) + (xcd - r) * q) + off; }
        const int nig = WGM * nN, gid = wgid / nig, fm = gid * WGM, gsz = (nM - fm) < WGM ? (nM - fm) : WGM;
        u.pm = fm + ((wgid % nig) % gsz); u.pn = (wgid % nig) / gsz; u.e = 0; u.lt = 0; return true;
    }
    __device__ __forceinline__ const char* a_base(const Gemm& g, const Unit& u) const { return (const char*)g.A + (size_t)u.pm * ((size_t)BM * g.K * 2); }
    __device__ __forceinline__ const char* b_base(const Gemm& g, const Unit& u) const { return (const char*)g.Bt + (size_t)u.pn * ((size_t)BM * g.K * 2); }
    __device__ __forceinline__ int gidx(int, int) const { return 0; }
};
template <bool GA> struct MoeOrder {
    static constexpr bool GATHER = GA;
    const LAS int* tmap; const LAS int* gtab; int ntiles, nN, G, c; size_t bstride;
    __device__ bool next(int i, Unit& u) const {
        const int L = i * G + c; if (L >= ntiles * nN) return false;
        const int mt = L / nN; const int v = tmap[mt]; u.pm = mt; u.pn = L - mt * nN; u.e = v >> 8; u.lt = v & 255; return true;
    }
    __device__ __forceinline__ const char* a_base(const Gemm& g, const Unit& u) const { return GA ? (const char*)g.A : (const char*)g.A + (size_t)u.pm * ((size_t)BM * g.K * 2); }
    __device__ __forceinline__ const char* b_base(const Gemm& g, const Unit& u) const { return (const char*)g.Bt + (size_t)u.e * bstride + (size_t)u.pn * ((size_t)BM * g.K * 2); }
    __device__ __forceinline__ int gidx(int ui, int r) const { return gtab[ui * 256 + r]; }
};

__device__ __forceinline__ unsigned cvt_pk_bf16(float lo, float hi) { return pk2(lo, hi); }

struct EpiBf16 {
    static constexpr bool PERM = true;
    bf16* O; int ldc;
    __device__ __forceinline__ void operator()(const f32x4 (&acc)[2][2][4][2], const Unit& u, int wr, int wc, int fr, int fq) const {
        const int row0 = u.pm * BM + wr * 64 + fr, col0 = u.pn * BM + wc * 32 + 8 * fq;
#pragma unroll
        for (int ai = 0; ai < 2; ++ai)
#pragma unroll
            for (int m = 0; m < 4; ++m) { bf16* rowp = O + (size_t)(row0 + ai * HALF + m * 16) * ldc + col0;
#pragma unroll
                for (int bj = 0; bj < 2; ++bj) { const f32x4 v0 = acc[ai][bj][m][0], v1 = acc[ai][bj][m][1];
                    v4u w; w.x = cvt_pk_bf16(v0[0], v0[1]); w.y = cvt_pk_bf16(v0[2], v0[3]); w.z = cvt_pk_bf16(v1[0], v1[1]); w.w = cvt_pk_bf16(v1[2], v1[3]);
                    *(v4u*)(rowp + bj * HALF) = w; } }
    }
};
struct EpiBf16Blk {
    static constexpr bool PERM = true;
    bf16* O; int M;
    __device__ __forceinline__ void operator()(const f32x4 (&acc)[2][2][4][2], const Unit& u, int wr, int wc, int fr, int fq) const {
        const int row0 = u.pm * BM + wr * 64 + fr, cin = wc * 32 + 8 * fq;
#pragma unroll
        for (int ai = 0; ai < 2; ++ai)
#pragma unroll
            for (int m = 0; m < 4; ++m) {
#pragma unroll
                for (int bj = 0; bj < 2; ++bj) { const f32x4 v0 = acc[ai][bj][m][0], v1 = acc[ai][bj][m][1];
                    v4u w; w.x = cvt_pk_bf16(v0[0], v0[1]); w.y = cvt_pk_bf16(v0[2], v0[3]); w.z = cvt_pk_bf16(v1[0], v1[1]); w.w = cvt_pk_bf16(v1[2], v1[3]);
                    __builtin_nontemporal_store(w, (v4u*)(O + ((size_t)(2 * u.pn + bj) * M + (row0 + ai * HALF + m * 16)) * 128 + cin)); } }
    }
};
struct EpiResF32 {
    static constexpr bool PERM = false;
    const float* res; float* out; int ldc;
    __device__ __forceinline__ void operator()(const f32x4 (&acc)[2][2][4][2], const Unit& u, int wr, int wc, int fr, int fq) const {
        const int row0 = u.pm * BM + wr * 64 + fr, col0 = u.pn * BM + wc * 32 + 4 * fq;
#pragma unroll
        for (int ai = 0; ai < 2; ++ai)
#pragma unroll
            for (int m = 0; m < 4; ++m) { const size_t off = (size_t)(row0 + ai * HALF + m * 16) * ldc + col0;
#pragma unroll
                for (int bj = 0; bj < 2; ++bj)
#pragma unroll
                    for (int n = 0; n < 2; ++n) { const f32x4 r = *(const f32x4*)(res + off + bj * HALF + n * 16); *(f32x4*)(out + off + bj * HALF + n * 16) = r + acc[ai][bj][m][n]; } }
    }
};
template <bool RES_F32> struct EpiResH {
    static constexpr bool PERM = true;
    const void* res; bf16* out; int ldc;
    __device__ __forceinline__ void operator()(const f32x4 (&acc)[2][2][4][2], const Unit& u, int wr, int wc, int fr, int fq) const {
        const int row0 = u.pm * BM + wr * 64 + fr, col0 = u.pn * BM + wc * 32 + 8 * fq;
#pragma unroll
        for (int ai = 0; ai < 2; ++ai)
#pragma unroll
            for (int m = 0; m < 4; ++m) { const size_t off = (size_t)(row0 + ai * HALF + m * 16) * ldc + col0;
#pragma unroll
                for (int bj = 0; bj < 2; ++bj) { f32x4 r0, r1;
                    if constexpr (RES_F32) { const float* rp = (const float*)res + off + bj * HALF; r0 = *(const f32x4*)rp; r1 = *(const f32x4*)(rp + 4); }
                    else { const v4u h_ = *(const v4u*)((const bf16*)res + off + bj * HALF);
                        r0 = (f32x4){__uint_as_float(h_.x << 16), __uint_as_float(h_.x & 0xffff0000u), __uint_as_float(h_.y << 16), __uint_as_float(h_.y & 0xffff0000u)};
                        r1 = (f32x4){__uint_as_float(h_.z << 16), __uint_as_float(h_.z & 0xffff0000u), __uint_as_float(h_.w << 16), __uint_as_float(h_.w & 0xffff0000u)}; }
                    const f32x4 v0 = r0 + acc[ai][bj][m][0], v1 = r1 + acc[ai][bj][m][1];
                    v4u w; w.x = cvt_pk_bf16(v0[0], v0[1]); w.y = cvt_pk_bf16(v0[2], v0[3]); w.z = cvt_pk_bf16(v1[0], v1[1]); w.w = cvt_pk_bf16(v1[2], v1[3]);
                    *(v4u*)(out + off + bj * HALF) = w; } }
    }
};
struct EpiSwiGlu {
    static constexpr bool PERM = true;
    bf16* H;
    __device__ __forceinline__ void operator()(const f32x4 (&acc)[2][2][4][2], const Unit& u, int wr, int wc, int fr, int fq) const {
        const int row0 = u.pm * BM + wr * 64 + fr, col0 = u.pn * 128 + wc * 32 + 8 * fq;
#pragma unroll
        for (int ai = 0; ai < 2; ++ai)
#pragma unroll
            for (int m = 0; m < 4; ++m) { bf16* rowp = H + (size_t)(row0 + ai * HALF + m * 16) * DEXP + col0;
                float o[8];
#pragma unroll
                for (int n = 0; n < 2; ++n)
#pragma unroll
                    for (int j = 0; j < 4; ++j) { const float g = acc[ai][0][m][n][j], up = acc[ai][1][m][n][j]; o[n * 4 + j] = (g * __builtin_amdgcn_rcpf(1.f + __expf(-g))) * up; }
                v4u w; w.x = cvt_pk_bf16(o[0], o[1]); w.y = cvt_pk_bf16(o[2], o[3]); w.z = cvt_pk_bf16(o[4], o[5]); w.w = cvt_pk_bf16(o[6], o[7]);
                *(v4u*)rowp = w; }
    }
};
struct EpiSwiGlu8 {
    static constexpr bool PERM = true;
    unsigned char* H;
    __device__ __forceinline__ void operator()(const f32x4 (&acc)[2][2][4][2], const Unit& u, int wr, int wc, int fr, int fq) const {
        const int row0 = u.pm * BM + wr * 64 + fr, col0 = u.pn * 128 + wc * 32 + 8 * fq;
#pragma unroll
        for (int ai = 0; ai < 2; ++ai)
#pragma unroll
            for (int m = 0; m < 4; ++m) { unsigned char* rowp = H + (size_t)(row0 + ai * HALF + m * 16) * DEXP + col0;
                float o[8];
#pragma unroll
                for (int n = 0; n < 2; ++n)
#pragma unroll
                    for (int j = 0; j < 4; ++j) { const float g = acc[ai][0][m][n][j], up = acc[ai][1][m][n][j]; o[n * 4 + j] = (g * __builtin_amdgcn_rcpf(1.f + __expf(-g))) * up; }
                int w0 = 0, w1 = 0;
                w0 = cvt2_fp8(o[0], o[1], w0, false); w0 = cvt2_fp8(o[2], o[3], w0, true);
                w1 = cvt2_fp8(o[4], o[5], w1, false); w1 = cvt2_fp8(o[6], o[7], w1, true);
                *(v2u*)rowp = (v2u){(unsigned)w0, (unsigned)w1}; }
    }
};
struct EpiScaleBf16 {
    static constexpr bool PERM = true;
    bf16* Y; int ldc; const float* wt; const LAS int* ecnt;
    __device__ __forceinline__ void operator()(const f32x4 (&acc)[2][2][4][2], const Unit& u, int wr, int wc, int fr, int fq) const {
        const int row0 = u.pm * BM + wr * 64 + fr, col0 = u.pn * BM + wc * 32 + 8 * fq;
        const int cnt = ecnt[u.e]; const float* wl = wt + (size_t)u.e * NTOK;
#pragma unroll
        for (int ai = 0; ai < 2; ++ai)
#pragma unroll
            for (int m = 0; m < 4; ++m) { const int lr = u.lt * 256 + wr * 64 + fr + ai * HALF + m * 16; const float s = lr < cnt ? wl[lr] : 0.f;
                bf16* rowp = Y + (size_t)(row0 + ai * HALF + m * 16) * ldc + col0;
#pragma unroll
                for (int bj = 0; bj < 2; ++bj) { const f32x4 v0 = acc[ai][bj][m][0] * s, v1 = acc[ai][bj][m][1] * s;
                    v4u w; w.x = cvt_pk_bf16(v0[0], v0[1]); w.y = cvt_pk_bf16(v0[2], v0[3]); w.z = cvt_pk_bf16(v1[0], v1[1]); w.w = cvt_pk_bf16(v1[2], v1[3]);
                    *(v4u*)(rowp + bj * HALF) = w; } }
    }
};

struct EpiScaleF8 {
    static constexpr bool PERM = true;
    unsigned char* Y; int ldc; const float* wt; const LAS int* ecnt;
    __device__ __forceinline__ void operator()(const f32x4 (&acc)[2][2][4][2], const Unit& u, int wr, int wc, int fr, int fq) const {
        const int row0 = u.pm * BM + wr * 64 + fr, col0 = u.pn * BM + wc * 32 + 8 * fq;
        const int cnt = ecnt[u.e]; const float* wl = wt + (size_t)u.e * NTOK;
#pragma unroll
        for (int ai = 0; ai < 2; ++ai)
#pragma unroll
            for (int m = 0; m < 4; ++m) { const int lr = u.lt * 256 + wr * 64 + fr + ai * HALF + m * 16; const float s = lr < cnt ? wl[lr] * 16.f : 0.f;
                unsigned char* rowp = Y + (size_t)(row0 + ai * HALF + m * 16) * ldc + col0;
#pragma unroll
                for (int bj = 0; bj < 2; ++bj) { const f32x4 v0 = acc[ai][bj][m][0] * s, v1 = acc[ai][bj][m][1] * s;
                    int w0 = 0, w1 = 0;
                    w0 = cvt2_fp8(v0[0], v0[1], w0, false); w0 = cvt2_fp8(v0[2], v0[3], w0, true);
                    w1 = cvt2_fp8(v1[0], v1[1], w1, false); w1 = cvt2_fp8(v1[2], v1[3], w1, true);
                    *(v2u*)(rowp + bj * HALF) = (v2u){(unsigned)w0, (unsigned)w1}; } }
    }
};

template <class Epi, class Sched, bool ALIGN_EPI, bool FP8 = false>
__device__ __forceinline__ void gemm_phase(LAS unsigned char* lds, const Gemm g, const Sched& S, const Epi& E) {
    constexpr bool GA = Sched::GATHER;
    int tid_ = threadIdx.x; asm volatile("" : "+v"(tid_));
    const int tid = tid_, wid = __builtin_amdgcn_readfirstlane(tid >> 6), lane = tid & 63, wr = wid >> 2, wc = wid & 3, fr = lane & 15, fq = lane >> 4;
    const int K = g.K, nt = K / BK;
    unsigned voffA[2], voffB[2], gC[2]; int gR[2];
#pragma unroll
    for (int i = 0; i < 2; ++i) { int R, C; stage_rc(tid * 16 + i * 8192, R, C); const int Rb = Epi::PERM ? ((R & ~31) + perm32(R & 31)) : R;
        voffA[i] = (unsigned)(R * K + C) * 2u; voffB[i] = (unsigned)(Rb * K + C) * 2u; gR[i] = R; gC[i] = (unsigned)C * 2u; }
    const size_t kstep = (size_t)(BK * 2);
    const size_t hstep = (size_t)HALF * K * 2;
    const size_t H1 = GA ? 0 : hstep;
    const unsigned ldsw = (unsigned)wid * 1024u;
    const int aoff = lds_byte(wr * 64 + fr, fq * 8), boff = lds_byte(wc * 32 + fr, fq * 8);
    unsigned vA0[2], vA1[2], vT1[2];
#define PG8_LOADG(ui_) do { int tg_ = threadIdx.x; asm volatile("" : "+v"(tg_)); _Pragma("unroll") for (int _i = 0; _i < 2; ++_i) { int R_, C_; stage_rc(tg_ * 16 + _i * 8192, R_, C_); vA0[_i] = (unsigned)S.gidx((ui_), R_) * (unsigned)(K * 2) + (unsigned)C_ * 2u; vA1[_i] = (unsigned)S.gidx((ui_), HALF + R_) * (unsigned)(K * 2) + (unsigned)C_ * 2u; } } while (0)
    unsigned (&rA0)[2] = GA ? vA0 : voffA; unsigned (&rA1)[2] = GA ? vA1 : voffA; unsigned (&rT1)[2] = GA ? vT1 : voffA;
#define PG8_SA(b, h) (((b) * 2 + (h)) * HTB)
#define PG8_SB(b, h) ((4 + (b) * 2 + (h)) * HTB)
#define PG8_STAGE(bufoff, gbase, voff) do { unsigned long long gb_ = (unsigned long long)(gbase); asm volatile("" : "+s"(gb_));     \
        _Pragma("unroll") for (int _i = 0; _i < 2; ++_i) { unsigned vo_ = (voff)[_i]; asm volatile("" : "+v"(vo_));     \
        __builtin_amdgcn_global_load_lds((const unsigned*)((const char*)gb_ + vo_), (LAS unsigned*)(lds + (bufoff) + ldsw + _i * 8192), 16, 0, 0); } } while (0)
#define PG8_LDA(dst, b, h) do { _Pragma("unroll") for (int m = 0; m < 4; ++m) { if constexpr (FP8) { \
            dst##8[m].lo = *(const LAS v4i_*)(lds + PG8_SA(b, h) + aoff + m * 2048); dst##8[m].hi = *(const LAS v4i_*)(lds + PG8_SA(b, h) + aoff + m * 2048 + 1024); } \
        else { _Pragma("unroll") for (int k = 0; k < 2; ++k) dst[m][k] = *(const LAS bf16x8*)(lds + PG8_SA(b, h) + aoff + m * 2048 + k * 1024); } } } while (0)
#define PG8_LDB(dst, b, h) do { _Pragma("unroll") for (int n = 0; n < 2; ++n) { if constexpr (FP8) { \
            dst##8[n].lo = *(const LAS v4i_*)(lds + PG8_SB(b, h) + boff + n * 2048); dst##8[n].hi = *(const LAS v4i_*)(lds + PG8_SB(b, h) + boff + n * 2048 + 1024); } \
        else { _Pragma("unroll") for (int k = 0; k < 2; ++k) dst[n][k] = *(const LAS bf16x8*)(lds + PG8_SB(b, h) + boff + n * 2048 + k * 1024); } } } while (0)
#define PG8_MMA(ai, bj, At, Bt) do { __builtin_amdgcn_s_setprio(1); _Pragma("unroll") for (int m = 0; m < 4; ++m) _Pragma("unroll") for (int n = 0; n < 2; ++n) { \
        if constexpr (FP8) asm volatile("v_mfma_scale_f32_16x16x128_f8f6f4 %0, %1, %2, %0, %3, %4 op_sel_hi:[0,0,0]" : "+v"(acc[ai][bj][m][n]) : "v"(Bt##8[n]), "v"(At##8[m]), "v"(wsc_), "v"(one_));     \
        else { _Pragma("unroll") for (int k = 0; k < 2; ++k) acc[ai][bj][m][n] = __builtin_amdgcn_mfma_f32_16x16x32_bf16(Bt[n][k], At[m][k], acc[ai][bj][m][n], 0, 0, 0); } } \
        __builtin_amdgcn_s_setprio(0); } while (0)
#define PG8_WAIT_V(n) asm volatile("s_waitcnt vmcnt(" #n ")" ::: "memory")
#define PG8_WAIT_L(n) asm volatile("s_waitcnt lgkmcnt(" #n ")" ::: "memory")
#define PG8_BAR __builtin_amdgcn_s_barrier()
#define PG8_SCHED __builtin_amdgcn_sched_barrier(0)
    Unit cur, nxt; int ui = 0;
    if (!S.next(0, cur)) return;
    f32x4 acc[2][2][4][2];
#pragma unroll
    for (int a = 0; a < 2; ++a)
#pragma unroll
        for (int b = 0; b < 2; ++b)
#pragma unroll
            for (int m = 0; m < 4; ++m)
#pragma unroll
                for (int n = 0; n < 2; ++n) acc[a][b][m][n] = (f32x4){0.f, 0.f, 0.f, 0.f};
    typedef int v8i_ __attribute__((ext_vector_type(8))); typedef int v4i_ __attribute__((ext_vector_type(4)));
    const int wsc_ = (int)g.wscale, one_ = 0x7f7f7f7f;
    bf16x8 At[4][2], B0[2][2], B1[2][2]; v8i_ At8[4], B08[2], B18[2];
    const char* cA = S.a_base(g, cur); const char* cB = S.b_base(g, cur);
    if constexpr (GA) { PG8_LOADG(0); vT1[0] = vA1[0]; vT1[1] = vA1[1]; }
    PG8_STAGE(PG8_SB(0, 0), cB, voffB); PG8_STAGE(PG8_SB(0, 1), cB + hstep, voffB); PG8_STAGE(PG8_SA(0, 0), cA, rA0); PG8_STAGE(PG8_SA(0, 1), cA + H1, rA1);
    if (wr == 1) PG8_BAR;
    PG8_WAIT_V(2); PG8_BAR;
    PG8_STAGE(PG8_SB(1, 0), cB + kstep, voffB); PG8_STAGE(PG8_SA(1, 0), cA + kstep, rA0); PG8_STAGE(PG8_SB(1, 1), cB + hstep + kstep, voffB);
    PG8_WAIT_V(6); PG8_BAR;
    for (;;) {
        const bool has_next = S.next(ui + 1, nxt);
        const char* nA = has_next ? S.a_base(g, nxt) : cA; const char* nB = has_next ? S.b_base(g, nxt) : cB;
#pragma unroll 1
        for (int t = 0; t < nt; t += 2) {
            const bool last = (t == nt - 2);
            const char* a1 = cA + (size_t)(t + 1) * kstep;
            const char* a2 = last ? nA : cA + (size_t)(t + 2) * kstep; const char* b2 = last ? nB : cB + (size_t)(t + 2) * kstep;
            const char* a3 = a2 + kstep; const char* b3 = b2 + kstep;
            if constexpr (GA) { if (last && has_next) PG8_LOADG(ui + 1); }
            PG8_LDB(B0, 0, 0); PG8_LDB(B1, 0, 1); PG8_SCHED; PG8_LDA(At, 0, 0); PG8_STAGE(PG8_SA(1, 1), a1 + H1, rT1);
            PG8_WAIT_V(8); PG8_WAIT_L(0); PG8_BAR; PG8_MMA(0, 0, At, B0); PG8_MMA(0, 1, At, B1); PG8_BAR; PG8_SCHED;
            PG8_LDA(At, 0, 1); PG8_STAGE(PG8_SB(0, 0), b2, voffB); PG8_STAGE(PG8_SB(0, 1), b2 + hstep, voffB); PG8_STAGE(PG8_SA(0, 0), a2, rA0);
            PG8_WAIT_V(8); PG8_WAIT_L(0); PG8_BAR; PG8_MMA(1, 0, At, B0); PG8_MMA(1, 1, At, B1); PG8_BAR; PG8_SCHED;
            PG8_LDB(B0, 1, 0); PG8_LDB(B1, 1, 1); PG8_SCHED; PG8_LDA(At, 1, 0); PG8_STAGE(PG8_SA(0, 1), a2 + H1, rA1);
            PG8_WAIT_V(8); PG8_WAIT_L(0); PG8_BAR; PG8_MMA(0, 0, At, B0); PG8_MMA(0, 1, At, B1); PG8_BAR; PG8_SCHED;
            PG8_LDA(At, 1, 1); PG8_STAGE(PG8_SB(1, 0), b3, voffB); PG8_STAGE(PG8_SB(1, 1), b3 + hstep, voffB); PG8_STAGE(PG8_SA(1, 0), a3, rA0);
            PG8_WAIT_V(8); PG8_WAIT_L(0); PG8_BAR; PG8_MMA(1, 0, At, B0); PG8_MMA(1, 1, At, B1); PG8_BAR; PG8_SCHED;
        }
        if constexpr (FP8) asm volatile("s_nop 15\n\ts_nop 15" ::: "memory");
        if constexpr (ALIGN_EPI) { if (wr == 0) PG8_BAR; }
        E(acc, cur, wr, wc, fr, fq);
        if (!has_next) break;
#pragma unroll
        for (int a = 0; a < 2; ++a)
#pragma unroll
            for (int b = 0; b < 2; ++b)
#pragma unroll
                for (int m = 0; m < 4; ++m)
#pragma unroll
                    for (int n = 0; n < 2; ++n) acc[a][b][m][n] = (f32x4){0.f, 0.f, 0.f, 0.f};
        cur = nxt; cA = nA; cB = nB; ++ui;
        if constexpr (GA) { vT1[0] = vA1[0]; vT1[1] = vA1[1]; }
        if constexpr (ALIGN_EPI) { if (wr == 1) PG8_BAR; }
    }
    PG8_WAIT_V(0);
    if constexpr (!ALIGN_EPI) { if (wr == 0) PG8_BAR; }
    PG8_BAR;
#undef PG8_LOADG
#undef PG8_SA
#undef PG8_SB
#undef PG8_STAGE
#undef PG8_LDA
#undef PG8_LDB
#undef PG8_MMA
#undef PG8_WAIT_V
#undef PG8_WAIT_L
#undef PG8_BAR
#undef PG8_SCHED
}
}

constexpr size_t MiB = 1u << 20;
constexpr size_t WS_CTL = 0, CTL_ZERO_BYTES = 1 * MiB;
constexpr size_t SZ_WIN = (size_t)NP * DM * 2, SZ_WDT = (size_t)16 * DM * 2, SZ_WR = (size_t)48 * DM * 2, SZ_WOUT = (size_t)DM * DM * 2;
constexpr size_t SZ_WGU1 = (size_t)1024 * DM * 2, SZ_WD1 = (size_t)DM * DEXP * 2;
constexpr size_t WS_WIN = 1 * MiB;
constexpr size_t WS_WDT = WS_WIN + NLAYER * SZ_WIN;
constexpr size_t WS_WR = WS_WDT + NLAYER * SZ_WDT;
constexpr size_t WS_WOUT = WS_WR + NLAYER * SZ_WR;
constexpr size_t WS_WGU = WS_WOUT + NLAYER * SZ_WOUT;
constexpr size_t WS_WD = WS_WGU + NLAYER * NEXP * SZ_WGU1;
constexpr size_t WS_P = WS_WD + NLAYER * NEXP * SZ_WD1;
constexpr size_t SZ_P = (size_t)NTOK * NP * 2;
constexpr size_t WS_Y = WS_P, SZ_Y = (size_t)PADROWS * DM * 2;
constexpr size_t WS_HID = WS_Y + SZ_Y, SZ_HID = (size_t)PADROWS * DEXP * 2;
static_assert(SZ_Y + SZ_HID <= SZ_P, "Y|HID overlay P");
constexpr size_t WS_U = WS_P + SZ_P, SZ_U = (size_t)NTOK * DM * 2;
constexpr size_t WS_DT = WS_U + SZ_U, SZ_DT = (size_t)NTOK * 16 * 4;
constexpr size_t WS_TOK = WS_DT + SZ_DT, SZ_TOK = (size_t)NEXP * NTOK * 4;
constexpr size_t WS_WT = WS_TOK + SZ_TOK;
constexpr size_t WS_SLOT = WS_WT + SZ_TOK, SZ_SLOT = (size_t)NTOK * 2 * 4;
constexpr size_t WS_ROT = WS_SLOT + SZ_SLOT, SZ_ROT = (size_t)SEQ * 64 * 4;
constexpr size_t WS_XC = WS_ROT + 2 * SZ_ROT, SZ_XC = (size_t)NTOK * CONVD * 2;
constexpr size_t HPU = 16384 + 16384 + 8192 + 512;
constexpr size_t WS_HP = WS_XC + SZ_XC, SZ_HP = (size_t)32 * 32 * HPU;
constexpr size_t WS_U8 = WS_XC;
constexpr size_t WS_SD = WS_HP + SZ_HP, SZ_SD = (size_t)8 * 16 * SEQ * 16;
constexpr size_t WS_H = WS_SD + SZ_SD, SZ_H = (size_t)NTOK * DM * 2;
constexpr size_t WS_END = WS_H + SZ_H;
static_assert(WS_END < 1000000000ull, "workspace map");
constexpr int CW_BAR = 4096;
constexpr int CW_CNT = 8192;
constexpr int RING_BYTES = 131072, LDSCTL_OFF = RING_BYTES, MISC_OFF = LDSCTL_OFF + 320;
constexpr int TAB_OFF = RING_BYTES + 1024;
constexpr int T_TMAP = 0, T_ECNT = 192, T_EBASE = 224, T_GTAB = 256, T_END = 256 + 1024;
constexpr int LDS_BYTES = 147456;
static_assert(TAB_OFF + T_END * 4 <= LDS_BYTES, "LDS map");
constexpr int NWAVES = 8;

#define XB_TMO      128
#define XB_XCNT(j)  (256  + 64 * (j))
#define XB_XSUB(j)  (1280 + 64 * (j))
#define XB_XGEN(j)  (2304 + 64 * (j))
#define XB_TOP      3328
#define XB_TOPGEN   3392
#define XCD_BAR_WORDS 3456
#define XB_SPIN_CAP (1u << 18)
__device__ __forceinline__ unsigned xb_ld(unsigned* p)              { return __hip_atomic_load(p, __ATOMIC_RELAXED, __HIP_MEMORY_SCOPE_AGENT); }
__device__ __forceinline__ unsigned xb_add(unsigned* p, unsigned v) { return __hip_atomic_fetch_add(p, v, __ATOMIC_RELAXED, __HIP_MEMORY_SCOPE_AGENT); }
__device__ __forceinline__ unsigned xb_xcc_id() { return (unsigned)__builtin_amdgcn_s_getreg((3 << 11) | 20) & 0xFu; }
#define XB_SPIN(cond, bar) do { unsigned _sp = 0; while (cond) { __builtin_amdgcn_s_sleep(1); \
    if ((++_sp & 255u) == 0u) { if (xb_ld(&(bar)[XB_TMO])) break; if (_sp > XB_SPIN_CAP) { atomicAdd(&(bar)[XB_TMO], 1u); break; } } } } while (0)
struct XcdBarrier { unsigned* bar; unsigned x; volatile LAS unsigned* st; };
__device__ __forceinline__ XcdBarrier xcd_barrier_post(unsigned* bar, volatile LAS unsigned* st) {
    XcdBarrier b; b.bar = bar; b.x = xb_xcc_id(); b.st = st;
    if (threadIdx.x == 0) (void)xb_add(&bar[XB_XCNT(b.x)], 1u);
    return b;
}
__device__ __forceinline__ void xcd_barrier_complete(unsigned* bar, unsigned x, unsigned& nloc, unsigned& nx) {
    const unsigned G = gridDim.x * gridDim.y * gridDim.z;
    unsigned sum, cnt, mine, sp = 0u;
    for (;;) {
        sum = 0u; cnt = 0u; mine = 0u;
#pragma unroll
        for (unsigned j = 0; j < 16; ++j) { const unsigned c = xb_ld(&bar[XB_XCNT(j)]); sum += c; cnt += (c > 0u) ? 1u : 0u; mine = (j == x) ? c : mine; }
        if (sum == G) break;
        __builtin_amdgcn_s_sleep(1);
        if ((++sp & 255u) == 0u) { if (xb_ld(&bar[XB_TMO])) break; if (sp > XB_SPIN_CAP) { atomicAdd(&bar[XB_TMO], 1u); break; } }
    }
    nloc = mine > 0u ? mine : 1u; nx = cnt > 0u ? cnt : 1u;
}
__device__ __forceinline__ void xcd_barrier(const XcdBarrier& b) {
    asm volatile("s_waitcnt vmcnt(0)" ::: "memory");
    __syncthreads();
    if (threadIdx.x == 0) {
        unsigned* bar = b.bar;
        __builtin_amdgcn_s_waitcnt(0);
        unsigned nloc = b.st[0], nx = b.st[1];
        if (nloc == 0u) { xcd_barrier_complete(bar, b.x, nloc, nx); b.st[0] = nloc; b.st[1] = nx; }
        const unsigned old = xb_add(&bar[XB_XSUB(b.x)], 1u);
        const unsigned gen = old / nloc;
        if (old + 1u == (gen + 1u) * nloc) {
            __builtin_amdgcn_fence(__ATOMIC_RELEASE, "agent");
            asm volatile("s_waitcnt vmcnt(0)" ::: "memory");
            const unsigned og = xb_add(&bar[XB_TOP], 1u);
            const unsigned tg = og / nx;
            if (og + 1u == (tg + 1u) * nx) xb_add(&bar[XB_TOPGEN], 1u);
            else XB_SPIN(xb_ld(&bar[XB_TOPGEN]) == tg, bar);
            __builtin_amdgcn_fence(__ATOMIC_ACQUIRE, "agent");
            xb_add(&bar[XB_XGEN(b.x)], 1u);
            asm volatile("s_waitcnt vmcnt(0)" ::: "memory");
        } else {
            XB_SPIN(xb_ld(&bar[XB_XGEN(b.x)]) == gen, bar);
            __builtin_amdgcn_fence(__ATOMIC_ACQUIRE, "agent");
            asm volatile("s_waitcnt vmcnt(0)" ::: "memory");
        }
    }
    __syncthreads();
}

struct Args { const float* in[21]; float* out; unsigned char* ws; int gp_lo, gp_hi; };
struct Frame {
    LAS unsigned char* lds;
    volatile LAS unsigned* MISC;
    LAS int* tab;
    unsigned* ctl;
    int tid, lane, wave, G, bid;
    float* out; unsigned char* ws;
};
enum { I_X = 0, I_ANW, I_WIN, I_CONVW, I_CONVB, I_DTB, I_ALOG, I_SSDD, I_SSDNW, I_HLB, I_HNW, I_WOUT, I_FNW, I_RGW, I_RGB, I_REW, I_REB, I_EWG, I_EWU, I_EWD, I_FINW };

__device__ __forceinline__ int gt0(const Frame& F) { return F.bid * (NWAVES * 64) + F.tid; }
struct TItem { const float* W; bf16* base; int N, K, kind, up, k0, n0; float sc; };
__device__ __forceinline__ bf16* titem_row(const TItem& t, int n) {
    if (n >= t.N) return nullptr;
    if (t.kind == 0) { if (n < DT_COL0) return t.base + (size_t)n * DM; if (n < DT_COL0 + 16) return nullptr; return t.base + (size_t)(n - 16) * DM; }
    if (t.kind == 1) return t.base + (size_t)n * t.K;
    return t.base + (size_t)((n >> 7) * 256 + t.up * 128 + (n & 127)) * DM;
}
constexpr int TI_IN = 32 * 209, TI_OUT = 32 * 64, TI_G = 32 * 16, TI_D = 8 * 64, TI_LAYER = TI_IN + TI_OUT + NEXP * (2 * TI_G + TI_D);
__device__ __forceinline__ void titem_decode(const Frame& F, const Args& A, int it, TItem& t) {
    const int l = it / TI_LAYER; int r = it - l * TI_LAYER; t.up = 0; t.sc = 1.f;
    if (r < TI_IN) { t.W = A.in[I_WIN] + (size_t)l * DM * IN_DIM; t.base = (bf16*)(F.ws + WS_WIN + l * SZ_WIN); t.N = IN_DIM; t.K = DM; t.kind = 0; }
    else if ((r -= TI_IN) < TI_OUT) { t.W = A.in[I_WOUT] + (size_t)l * DM * DM; t.base = (bf16*)(F.ws + WS_WOUT + l * SZ_WOUT); t.N = DM; t.K = DM; t.kind = 1; }
    else { r -= TI_OUT; const int e = r / (2 * TI_G + TI_D); r -= e * (2 * TI_G + TI_D); const size_t eo = (size_t)(l * NEXP + e);
        if (r < TI_G) { t.W = A.in[I_EWG] + eo * DM * DEXP; t.base = (bf16*)(F.ws + WS_WGU + eo * SZ_WGU1); t.N = DEXP; t.K = DM; t.kind = MOE_FP8 ? 3 : 2; t.sc = 64.f; }
        else if ((r -= TI_G) < TI_G) { t.W = A.in[I_EWU] + eo * DM * DEXP; t.base = (bf16*)(F.ws + WS_WGU + eo * SZ_WGU1); t.N = DEXP; t.K = DM; t.kind = MOE_FP8 ? 3 : 2; t.up = 1; t.sc = 64.f; }
        else { r -= TI_G; t.W = A.in[I_EWD] + eo * DEXP * DM; t.base = (bf16*)(F.ws + WS_WD + eo * SZ_WD1); t.N = DM; t.K = DEXP; t.kind = MOE_FP8 ? 4 : 1; t.sc = 32.f; } }
    const int nblk = (t.N + 31) / 32, kb = r / nblk, nb = r - kb * nblk; t.k0 = 64 * kb; t.n0 = 32 * nb;
}
__device__ __forceinline__ void titem_load(const TItem& t, f32x4 (&v)[8], int lane) {
    const int kq = lane >> 3, nc = t.n0 + 4 * (lane & 7); const bool ok = nc < t.N;
#pragma unroll
    for (int j = 0; j < 8; ++j) v[j] = ok ? *(const f32x4*)(t.W + (size_t)(t.k0 + kq + 8 * j) * t.N + nc) : (f32x4){0.f, 0.f, 0.f, 0.f};
}
__device__ __forceinline__ void titem_store(const TItem& t, const f32x4 (&v)[8], LAS float* scr, int lane) {
    const int kq = lane >> 3, c4 = lane & 7;
#pragma unroll
    for (int j = 0; j < 8; ++j)
#pragma unroll
        for (int e = 0; e < 4; ++e) scr[(kq + 8 * j) * 33 + 4 * c4 + e] = v[j][e];
    LDS_WAIT(); asm volatile("" ::: "memory");
    if (t.kind >= 3) {
        const int n = lane & 31, hf = lane >> 5; const LAS float* s = scr + (32 * hf) * 33 + n; v4u o[2];
#pragma unroll
        for (int q = 0; q < 8; ++q) { int w_ = 0;
            w_ = cvt2_fp8(s[(4 * q + 0) * 33] * t.sc, s[(4 * q + 1) * 33] * t.sc, w_, false);
            w_ = cvt2_fp8(s[(4 * q + 2) * 33] * t.sc, s[(4 * q + 3) * 33] * t.sc, w_, true);
            o[q >> 2][q & 3] = (unsigned)w_; }
        const int nn = t.n0 + n;
        if (nn < t.N) { unsigned char* dst = (unsigned char*)t.base + (t.kind == 3 ? (size_t)((nn >> 7) * 256 + t.up * 128 + (nn & 127)) * DM : (size_t)nn * t.K) + t.k0 + 32 * hf;
            *(v4u*)dst = o[0]; *(v4u*)(dst + 16) = o[1]; }
        LDS_WAIT(); asm volatile("" ::: "memory");
        return;
    }
    const int c = lane & 7;
#pragma unroll
    for (int j = 0; j < 4; ++j) { const int n = (lane >> 3) + 8 * j; const LAS float* s = scr + (8 * c) * 33 + n;
        v4u o; o.x = pk2(s[0 * 33], s[1 * 33]); o.y = pk2(s[2 * 33], s[3 * 33]); o.z = pk2(s[4 * 33], s[5 * 33]); o.w = pk2(s[6 * 33], s[7 * 33]);
        bf16* dst = titem_row(t, t.n0 + n); if (dst) *(v4u*)(dst + t.k0 + 8 * c) = o; }
    LDS_WAIT(); asm volatile("" ::: "memory");
}
#ifndef CONV_SPLIT_ITEMS
#define CONV_SPLIT_ITEMS 20000
#endif
constexpr int CONV_SPLIT = CONV_SPLIT_ITEMS;
#ifndef CT_ITEMS
#define CT_ITEMS 20000
#endif
constexpr int CT_LO = NLAYER * (32 * 209 + 32 * 64 + NEXP * (2 * 32 * 16 + 8 * 64)) - CT_ITEMS;
constexpr int G1_WGS = 192;
static_assert(CONV_SPLIT >= TI_IN && CONV_SPLIT <= NLAYER * TI_LAYER, "conversion split");
__device__ __forceinline__ void convert_items(Frame& F, const Args& A, int lo, int hi, int gw, int NGW) {
    LAS float* scr = (LAS float*)(F.lds + F.wave * 16384);
    for (int it = lo + gw; it < hi; it += 4 * NGW) {
        TItem t0, t1, t2, t3; f32x4 v0[8], v1[8], v2[8], v3[8];
        const bool h1 = it + NGW < hi, h2 = it + 2 * NGW < hi, h3 = it + 3 * NGW < hi;
        titem_decode(F, A, it, t0); titem_load(t0, v0, F.lane);
        if (h1) { titem_decode(F, A, it + NGW, t1); titem_load(t1, v1, F.lane); }
        if (h2) { titem_decode(F, A, it + 2 * NGW, t2); titem_load(t2, v2, F.lane); }
        if (h3) { titem_decode(F, A, it + 3 * NGW, t3); titem_load(t3, v3, F.lane); }
        titem_store(t0, v0, scr, F.lane);
        if (h1) titem_store(t1, v1, scr, F.lane);
        if (h2) titem_store(t2, v2, scr, F.lane);
        if (h3) titem_store(t3, v3, scr, F.lane);
    }
}
__device__ __forceinline__ void phase_prologue(Frame& F, const Args& A) {
    const int gw = F.bid * NWAVES + F.wave, NGW = F.G * NWAVES;
    convert_items(F, A, 0, CONV_SPLIT, gw, NGW);
    for (int i = gt0(F); i < SEQ * 64; i += F.G * NWAVES * 64) { const int pos = i >> 6, ri = i & 63; float sn, cs; sincosf((float)pos * powf(10000.f, -(float)ri / 64.f), &sn, &cs);
        ((float*)(F.ws + WS_ROT))[i] = cs; ((float*)(F.ws + WS_ROT + SZ_ROT))[i] = sn; }
    const int gt = F.bid * (NWAVES * 64) + F.tid, NGT = F.G * NWAVES * 64;
    for (int i = gt; i < NLAYER * 16 * DM; i += NGT) { const int l = i / (16 * DM), j = (i / DM) % 16, k = i % DM;
        ((bf16*)(F.ws + WS_WDT))[i] = (bf16)f2bf(A.in[I_WIN][(size_t)l * DM * IN_DIM + (size_t)k * IN_DIM + DT_COL0 + j]); }
    for (int i = gt; i < NLAYER * 48 * DM; i += NGT) { const int l = i / (48 * DM), j = (i / DM) % 48, k = i % DM;
        float v = 0.f; if (j < 4) v = A.in[I_RGW][((size_t)l * DM + k) * 4 + j]; else if (j < 36) v = A.in[I_REW][((size_t)l * DM + k) * 32 + (j - 4)];
        ((bf16*)(F.ws + WS_WR))[i] = (bf16)f2bf(v); }
}

template <int NCT>
__device__ __forceinline__ void mini_gemm16(const bf16* A, const bf16* Bt, f32x4 (&acc)[NCT], int lane) {
    const int fr = lane & 15, fq = lane >> 4;
#pragma unroll
    for (int c = 0; c < NCT; ++c) acc[c] = (f32x4){0.f, 0.f, 0.f, 0.f};
    const bf16* ap = A + (size_t)fr * DM + fq * 8; const bf16* bp = Bt + (size_t)fr * DM + fq * 8;
#pragma unroll 4
    for (int ks = 0; ks < DM / 32; ++ks) {
        const bf16x8 a = *(const bf16x8*)(ap + ks * 32);
#pragma unroll
        for (int c = 0; c < NCT; ++c) { const bf16x8 b = *(const bf16x8*)(bp + (size_t)c * 16 * DM + ks * 32); acc[c] = __builtin_amdgcn_mfma_f32_16x16x32_bf16(a, b, acc[c], 0, 0, 0); }
    }
}

__device__ __forceinline__ void build_tables(Frame& F, int l) {
    if (F.tid == 0) { int run = 0;
        for (int e = 0; e < NEXP; ++e) { const int c = (int)__hip_atomic_load(F.ctl + CW_CNT + (l * NEXP + e) * 64, RLX_AGENT); const int nt = (c + 255) >> 8;
            F.tab[T_ECNT + e] = c; F.tab[T_EBASE + e] = run; for (int t = 0; t < nt; ++t) F.tab[T_TMAP + run + t] = (e << 8) | t; run += nt; }
        F.MISC[16] = (unsigned)run; }
    __syncthreads();
}

template <int MODE, int NR, bool F8 = false, bool HB = false>
__device__ __forceinline__ void norm_rows(const float* const (&src)[NR], float* const (&hdst)[NR], const bf16* const (&y0)[NR], const bf16* const (&y1)[NR], const f32x4 (&wv)[8], bf16* const (&udst)[NR], float* const (&fdst)[NR], int lane, unsigned char* const* u8 = nullptr) {
    f32x4 v[NR][8];
#pragma unroll
    for (int q = 0; q < NR; ++q)
#pragma unroll
        for (int j = 0; j < 8; ++j) { if constexpr (HB) { const v2u h_ = ((const v2u*)src[q] + lane)[64 * j]; v[q][j] = (f32x4){__uint_as_float(h_.x << 16), __uint_as_float(h_.x & 0xffff0000u), __uint_as_float(h_.y << 16), __uint_as_float(h_.y & 0xffff0000u)}; }
            else v[q][j] = ((const f32x4*)src[q] + lane)[64 * j]; }
    if (MODE >= 1) {
#pragma unroll
        for (int q = 0; q < NR; ++q) {
#if MOE_FP8
            unsigned ya[8], yb[8];
#pragma unroll
            for (int j = 0; j < 8; ++j) { ya[j] = *((const unsigned*)y0[q] + lane + 64 * j); yb[j] = *((const unsigned*)y1[q] + lane + 64 * j); }
#pragma unroll
            for (int j = 0; j < 8; ++j) { const f32x2 a0 = __builtin_amdgcn_cvt_pk_f32_fp8((int)ya[j], false), a1 = __builtin_amdgcn_cvt_pk_f32_fp8((int)ya[j], true), b0 = __builtin_amdgcn_cvt_pk_f32_fp8((int)yb[j], false), b1 = __builtin_amdgcn_cvt_pk_f32_fp8((int)yb[j], true);
                v[q][j][0] += (a0.x + b0.x) * 0.0625f; v[q][j][1] += (a0.y + b0.y) * 0.0625f; v[q][j][2] += (a1.x + b1.x) * 0.0625f; v[q][j][3] += (a1.y + b1.y) * 0.0625f; }
#else
            v2u ya[8], yb[8];
#pragma unroll
            for (int j = 0; j < 8; ++j) { ya[j] = *((const v2u*)y0[q] + lane + 64 * j); yb[j] = *((const v2u*)y1[q] + lane + 64 * j); }
#pragma unroll
            for (int j = 0; j < 8; ++j) { const v2u a = ya[j], b = yb[j];
                v[q][j][0] += __uint_as_float(a.x << 16) + __uint_as_float(b.x << 16); v[q][j][1] += __uint_as_float(a.x & 0xffff0000u) + __uint_as_float(b.x & 0xffff0000u);
                v[q][j][2] += __uint_as_float(a.y << 16) + __uint_as_float(b.y << 16); v[q][j][3] += __uint_as_float(a.y & 0xffff0000u) + __uint_as_float(b.y & 0xffff0000u); }
#endif
        }
    }
#pragma unroll
    for (int q = 0; q < NR; ++q) {
        if (MODE == 1) {
#pragma unroll
            for (int j = 0; j < 8; ++j) { if constexpr (HB) { v2u p; p.x = pk2(v[q][j][0], v[q][j][1]); p.y = pk2(v[q][j][2], v[q][j][3]); ((v2u*)hdst[q] + lane)[64 * j] = p;
                    v[q][j] = (f32x4){__uint_as_float(p.x << 16), __uint_as_float(p.x & 0xffff0000u), __uint_as_float(p.y << 16), __uint_as_float(p.y & 0xffff0000u)}; }
                else ((f32x4*)hdst[q] + lane)[64 * j] = v[q][j]; }
        }
        float s = 0.f;
#pragma unroll
        for (int j = 0; j < 8; ++j) s += (v[q][j][0] * v[q][j][0] + v[q][j][1] * v[q][j][1]) + (v[q][j][2] * v[q][j][2] + v[q][j][3] * v[q][j][3]);
        const float rstd = 1.f / sqrtf(wave_sum(s) * (1.f / DM) + EPS);
#pragma unroll
        for (int j = 0; j < 8; ++j) { const f32x4 o = v[q][j] * rstd * wv[j];
            if (MODE == 2) ((f32x4*)fdst[q] + lane)[64 * j] = o;
            else { v2u p; p.x = pk2(o[0], o[1]); p.y = pk2(o[2], o[3]); ((v2u*)udst[q] + lane)[64 * j] = p;
                if constexpr (F8) { int w_ = 0; w_ = cvt2_fp8(o[0], o[1], w_, false); w_ = cvt2_fp8(o[2], o[3], w_, true); ((unsigned*)u8[q] + lane)[64 * j] = (unsigned)w_; } } }
    }
}
__device__ __forceinline__ void load_normw(const float* w, f32x4 (&wv)[8], int lane) {
#pragma unroll
    for (int j = 0; j < 8; ++j) wv[j] = ((const f32x4*)w + lane)[64 * j];
}

__device__ __forceinline__ void phase_norm1(Frame& F, const Args& A, int l) {
    bf16* U = (bf16*)(F.ws + WS_U); const bf16* Y = (const bf16*)(F.ws + WS_Y); const int* slot = (const int*)(F.ws + WS_SLOT);
    f32x4 wv[8]; load_normw(A.in[I_ANW] + l * DM, wv, F.lane);
    if (l > 0) build_tables(F, l - 1);
    for (int blk = F.bid; blk < NTOK / 64; blk += F.G) {
        const int row0 = blk * 64;
        for (int r = 0; r < 8; r += 2) { const int row = row0 + F.wave * 8 + r;
            const float* src[2]; float* hd[2]; const bf16* ya[2]; const bf16* yb[2]; bf16* ud[2]; float* fd[2] = {nullptr, nullptr};
#pragma unroll
            for (int q = 0; q < 2; ++q) { const int rw = row + q; ud[q] = U + (size_t)rw * DM;
                if (l == 0) { src[q] = A.in[I_X] + (size_t)rw * DM; hd[q] = nullptr; ya[q] = nullptr; yb[q] = nullptr; }
                else { const int s0 = slot[rw * 2], s1 = slot[rw * 2 + 1];
                    ya[q] = Y + ((size_t)F.tab[T_EBASE + (s0 >> 16)] * 256 + (s0 & 0xffff)) * (MOE_FP8 ? DM / 2 : DM); yb[q] = Y + ((size_t)F.tab[T_EBASE + (s1 >> 16)] * 256 + (s1 & 0xffff)) * (MOE_FP8 ? DM / 2 : DM);
                    src[q] = H_BF16 ? (const float*)((const bf16*)(F.ws + WS_H) + (size_t)rw * DM) : F.out + (size_t)rw * DM; hd[q] = H_BF16 ? (float*)((bf16*)(F.ws + WS_H) + (size_t)rw * DM) : F.out + (size_t)rw * DM; } }
            if (l == 0) norm_rows<0, 2>(src, hd, ya, yb, wv, ud, fd, F.lane); else norm_rows<1, 2, false, H_BF16>(src, hd, ya, yb, wv, ud, fd, F.lane);
        }
        VM_WAIT(); __syncthreads();
        if (F.wave < 4) { f32x4 acc[1]; const int rb = row0 + F.wave * 16;
            mini_gemm16<1>(U + (size_t)rb * DM, (const bf16*)(F.ws + WS_WDT + l * SZ_WDT), acc, F.lane);
            float* DT = (float*)(F.ws + WS_DT);
#pragma unroll
            for (int j = 0; j < 4; ++j) DT[(size_t)(rb + (F.lane >> 4) * 4 + j) * 16 + (F.lane & 15)] = acc[0][j]; }
    }
}

__device__ __forceinline__ void phase_norm2(Frame& F, const Args& A, int l) {
    bf16* U = (bf16*)(F.ws + WS_U); f32x4 wv[8]; load_normw(A.in[I_FNW] + l * DM, wv, F.lane);
    LAS float* lg = (LAS float*)F.lds;
    LAS int* s_e = (LAS int*)(F.lds + 16384); LAS float* s_w = (LAS float*)(F.lds + 16384 + 512); LAS int* s_rank = (LAS int*)(F.lds + 16384 + 1024);
    LAS int* lcnt = (LAS int*)(F.lds + 16384 + 1536); LAS int* lbase = (LAS int*)(F.lds + 16384 + 1664);
    int* tokl = (int*)(F.ws + WS_TOK); float* wtl = (float*)(F.ws + WS_WT); int* slot = (int*)(F.ws + WS_SLOT);
    for (int blk = F.bid; blk < NTOK / 64; blk += F.G) {
        const int row0 = blk * 64;
        for (int r = 0; r < 8; r += 2) { const int row = row0 + F.wave * 8 + r;
            const float* src[2] = {H_BF16 ? (const float*)((const bf16*)(F.ws + WS_H) + (size_t)row * DM) : F.out + (size_t)row * DM, H_BF16 ? (const float*)((const bf16*)(F.ws + WS_H) + (size_t)(row + 1) * DM) : F.out + (size_t)(row + 1) * DM}; float* hd[2] = {nullptr, nullptr}; const bf16* ya[2] = {nullptr, nullptr};
            bf16* ud[2] = {U + (size_t)row * DM, U + (size_t)(row + 1) * DM}; float* fd[2] = {nullptr, nullptr};
            unsigned char* u8[2] = {F.ws + WS_U8 + (size_t)row * DM, F.ws + WS_U8 + (size_t)(row + 1) * DM};
            if (MOE_FP8) norm_rows<0, 2, true, H_BF16>(src, hd, ya, ya, wv, ud, fd, F.lane, u8); else norm_rows<0, 2, false, H_BF16>(src, hd, ya, ya, wv, ud, fd, F.lane); }
        if (F.tid < 32) lcnt[F.tid] = 0;
        VM_WAIT(); __syncthreads();
        if (F.wave < 4) { f32x4 acc[3]; const int rb = F.wave * 16;
            mini_gemm16<3>(U + (size_t)(row0 + rb) * DM, (const bf16*)(F.ws + WS_WR + l * SZ_WR), acc, F.lane);
#pragma unroll
            for (int c = 0; c < 3; ++c)
#pragma unroll
                for (int j = 0; j < 4; ++j) lg[(rb + (F.lane >> 4) * 4 + j) * 48 + c * 16 + (F.lane & 15)] = acc[c][j]; }
        __syncthreads();
        if (F.tid < 64) { const LAS float* L = lg + F.tid * 48;
            const float* bg = A.in[I_RGB] + l * 4; const float* be = A.in[I_REB] + l * 32;
            float gl[4]; int g = 0;
#pragma unroll
            for (int j = 0; j < 4; ++j) gl[j] = L[j] + bg[j];
#pragma unroll
            for (int j = 1; j < 4; ++j) if (gl[j] > gl[g]) g = j;
            float den = 0.f;
#pragma unroll
            for (int j = 0; j < 4; ++j) den += __expf(gl[j] - gl[g]);
            const float gate = 1.f / den;
            float el[8];
#pragma unroll
            for (int j = 0; j < 8; ++j) el[j] = L[4 + g * 8 + j] + be[g * 8 + j];
            int i1 = 0;
#pragma unroll
            for (int j = 1; j < 8; ++j) if (el[j] > el[i1]) i1 = j;
            int i2 = (i1 == 0) ? 1 : 0;
#pragma unroll
            for (int j = 0; j < 8; ++j) if (j != i1 && el[j] > el[i2]) i2 = j;
            const float w1 = gate / (1.f + __expf(el[i2] - el[i1])), w2 = gate - w1;
            s_e[2 * F.tid] = g * 8 + i1; s_e[2 * F.tid + 1] = g * 8 + i2; s_w[2 * F.tid] = w1; s_w[2 * F.tid + 1] = w2; }
        __syncthreads();
        if (F.tid < 128) s_rank[F.tid] = __hip_atomic_fetch_add(lcnt + s_e[F.tid], 1, __ATOMIC_RELAXED, __HIP_MEMORY_SCOPE_WORKGROUP);
        __syncthreads();
        if (F.tid < 32) { const int c = lcnt[F.tid]; lbase[F.tid] = c ? (int)__hip_atomic_fetch_add(F.ctl + CW_CNT + (l * NEXP + F.tid) * 64, (unsigned)c, RLX_AGENT) : 0; }
        __syncthreads();
        if (F.tid < 128) { const int e = s_e[F.tid], pos = lbase[e] + s_rank[F.tid], tok = row0 + (F.tid >> 1);
            tokl[(size_t)e * NTOK + pos] = tok; wtl[(size_t)e * NTOK + pos] = s_w[F.tid]; slot[tok * 2 + (F.tid & 1)] = (e << 16) | pos; }
        __syncthreads();
    }
}

enum { MX_RET = 0, MX_SSD = 1, MX_HGRN = 2 };
constexpr int IM_QA = 0, IM_QB = 16384, IM_KB = 32768, IM_KS = 73728, IM_V = 90112, IM_VS = 98304, IM_P = 106496, IM_ST = 114688;
constexpr int SM_CUM = TAB_OFF + T_END * 4, SM_TOT = SM_CUM + 512, SM_LAST = SM_TOT + 2048, SM_CW = SM_LAST + 512, SM_END = SM_CW + 6400;
static_assert(IM_ST + 16384 <= RING_BYTES && SM_END <= LDS_BYTES, "mixer LDS map");
typedef short s16x4 __attribute__((ext_vector_type(4)));
__device__ __forceinline__ unsigned img256(unsigned r, unsigned ch) { return 256u * r + 16u * (ch ^ (((r & 3u) << 2) | ((r >> 2) & 3u))); }
__device__ __forceinline__ unsigned imgP(unsigned r, unsigned ch) { return 128u * r + 16u * (ch ^ ((r >> 1) & 7u)); }
__device__ __forceinline__ unsigned imgV(unsigned r, unsigned ch) { return 128u * r + 16u * (ch ^ ((((r >> 1) & 1u) | (((r >> 3) & 1u) << 1)) << 1)); }
__device__ __forceinline__ bf16x8 tr_pair(LAS unsigned char* base, unsigned a0, unsigned a1) {
    const s16x4 lo = __builtin_amdgcn_ds_read_tr16_b64_v4i16((LAS s16x4*)(base + a0));
    const s16x4 hi = __builtin_amdgcn_ds_read_tr16_b64_v4i16((LAS s16x4*)(base + a1));
    return __builtin_shufflevector(lo, hi, 0, 1, 2, 3, 4, 5, 6, 7);
}
__device__ __forceinline__ void unpack8(const v4u x, float (&f)[8]) {
    f[0] = __uint_as_float(x.x << 16); f[1] = __uint_as_float(x.x & 0xffff0000u); f[2] = __uint_as_float(x.y << 16); f[3] = __uint_as_float(x.y & 0xffff0000u);
    f[4] = __uint_as_float(x.z << 16); f[5] = __uint_as_float(x.z & 0xffff0000u); f[6] = __uint_as_float(x.w << 16); f[7] = __uint_as_float(x.w & 0xffff0000u); }
__device__ __forceinline__ v4u pack8(const float (&f)[8]) { v4u w; w.x = pk2(f[0], f[1]); w.y = pk2(f[2], f[3]); w.z = pk2(f[4], f[5]); w.w = pk2(f[6], f[7]); return w; }


__device__ __forceinline__ void phase_conv(Frame& F, const Args& A, int l) {
    const bf16* P = (const bf16*)(F.ws + WS_P); bf16* XC = (bf16*)(F.ws + WS_XC);
    const float* cw = A.in[I_CONVW] + l * 4 * CONVD; const float* cb = A.in[I_CONVB] + l * CONVD;
    const int gt = F.bid * (NWAVES * 64) + F.tid, NGT = F.G * NWAVES * 64;
    for (int it = gt; it < (NTOK / 16) * 192; it += NGT) {
        const int rb = it / 192, cch = it - rb * 192, ch0 = cch * 8, row0 = rb * 16, tseq = row0 & (SEQ - 1);
        float cwr[4][8], cbr[8];
#pragma unroll
        for (int j = 0; j < 4; ++j) { const f32x4 a0 = *(const f32x4*)(cw + j * CONVD + ch0), a1 = *(const f32x4*)(cw + j * CONVD + ch0 + 4);
#pragma unroll
            for (int e = 0; e < 4; ++e) { cwr[j][e] = a0[e]; cwr[j][4 + e] = a1[e]; } }
        { const f32x4 b0 = *(const f32x4*)(cb + ch0), b1 = *(const f32x4*)(cb + ch0 + 4);
#pragma unroll
            for (int e = 0; e < 4; ++e) { cbr[e] = b0[e]; cbr[4 + e] = b1[e]; } }
        v4u xr[19];
#pragma unroll
        for (int rr = 0; rr < 19; ++rr) xr[rr] = (tseq + rr - 3 >= 0) ? *(const v4u*)(P + PB((size_t)(row0 + rr - 3), C_SX + ch0)) : (v4u){0u, 0u, 0u, 0u};
        float xs[4][8];
        unpack8(xr[0], xs[0]); unpack8(xr[1], xs[1]); unpack8(xr[2], xs[2]);
#pragma unroll
        for (int e = 0; e < 16; ++e) { float acc[8];
            unpack8(xr[e + 3], xs[(e + 3) & 3]);
#pragma unroll
            for (int c = 0; c < 8; ++c) acc[c] = cbr[c];
#pragma unroll
            for (int j = 0; j < 4; ++j)
#pragma unroll
                for (int c = 0; c < 8; ++c) acc[c] = fmaf(cwr[j][c], xs[(e + j) & 3][c], acc[c]);
#pragma unroll
            for (int c = 0; c < 8; ++c) acc[c] = siluf(acc[c]);
            *(v4u*)(XC + (size_t)(row0 + e) * CONVD + ch0) = pack8(acc); }
    }
}
#define IM_HCOPY(p) ((p) < 1024 ? IM_QB + (p) * 16 : ((p) < 2048 ? IM_KS + ((p) - 1024) * 16 : IM_P + ((p) - 2048) * 16))
#define MIX_BAR() do { asm volatile("s_waitcnt lgkmcnt(0)" ::: "memory"); __builtin_amdgcn_s_barrier(); asm volatile("" ::: "memory"); } while (0)

__device__ __forceinline__ void hgrn_prep_unit(Frame& F, const Args& A, int l, int b, int h, int n) {
    LAS unsigned char* lds = F.lds;
    const bf16* P = (const bf16*)(F.ws + WS_P);
    LAS float* totv = (LAS float*)(lds + SM_TOT); LAS float* lastv = (LAS float*)(lds + SM_LAST);
    const int tid = F.tid, w = F.wave;
    int lz = F.lane; asm volatile("" : "+v"(lz));
    const int fr = lz & 15, g = lz >> 4;
    const int ia = w >> 1, cc0 = (w & 1) * 2;
    const size_t row0 = (size_t)b * SEQ + n * 64;
    const int kk = tid & 127, sa = w >> 1;
    float hlb = 0.f;
    if (l > 0) { const float x0 = A.in[I_HLB][h * 128 + kk], x1 = A.in[I_HLB][512 + h * 128 + kk]; hlb = __builtin_amdgcn_rcpf(1.f + __expf(x0 - x1)); }
    const float hlbf = fmaxf(hlb, 1e-30f);
    bf16 hq[16], hf[16];
#pragma unroll
    for (int r = 0; r < 16; ++r) { const size_t pr_ = row0 + 16 * sa + r; hq[r] = P[PB(pr_, C_HQ + h * 128 + kk)]; hf[r] = P[PB(pr_, C_HF + h * 128 + kk)]; }
    float qv[16], kv[16], plr[16]; float pl = 1.f;
#pragma unroll
    for (int r = 0; r < 16; ++r) {
        const float qx = bf2f(hq[r]), fx = bf2f(hf[r]);
        const float sg = sigmf(fx);
        qv[r] = siluf(qx) * 0.08838834764831845f; kv[r] = (1.f - hlb) * (1.f - sg); pl *= hlbf + (1.f - hlb) * sg; plr[r] = pl; }
    totv[sa * 128 + kk] = pl;
    MIX_BAR();
    const float tt0 = totv[kk], tt1 = totv[128 + kk], tt2 = totv[256 + kk], tt3 = totv[384 + kk];
    if (sa == 0) lastv[kk] = tt0 * tt1 * tt2 * tt3;
    const float Ra = sa == 0 ? 1.f : (sa == 1 ? tt0 : (sa == 2 ? tt0 * tt1 : tt0 * tt1 * tt2));
    const float Ua = sa == 0 ? tt0 * tt1 * tt2 * tt3 : (sa == 1 ? tt1 * tt2 * tt3 : (sa == 2 ? tt2 * tt3 : tt3));
    const unsigned cb2 = (unsigned)(kk & 7) * 2u, chk = (unsigned)kk >> 3;
#pragma unroll
    for (int r = 0; r < 16; ++r) { const unsigned t = 16 * sa + r; const float qa = qv[r] * plr[r], ik = kv[r] * __builtin_amdgcn_rcpf(fmaxf(plr[r], 1e-30f));
        *(LAS bf16*)(lds + IM_QA + img256(t, chk) + cb2) = f2bf1(qa);
        *(LAS bf16*)(lds + IM_QB + img256(t, chk) + cb2) = f2bf1(qa * Ra);
        *(LAS bf16*)(lds + IM_KS + img256(t, chk) + cb2) = f2bf1(ik * Ua);
        float m = 1.f;
#pragma unroll
        for (int ap = 0; ap < 4; ++ap) if (ap >= sa) {
            if (ap > sa) m *= (ap == 1 ? tt0 : (ap == 2 ? tt1 : tt2));
            *(LAS bf16*)(lds + IM_KB + img256(16 * (ap * (ap + 1) / 2 + sa) + r, chk) + cb2) = f2bf1(ik * m); }
    }
    MIX_BAR();
    bf16x8 qa4[4];
#pragma unroll
    for (int ks = 0; ks < 4; ++ks) qa4[ks] = *(const LAS bf16x8*)(lds + IM_QA + img256(16 * ia + fr, 4 * ks + g));
#pragma unroll
    for (int jj = 0; jj < 2; ++jj) { const int jb = cc0 + jj; v2u pw = (v2u){0u, 0u};
        if (jb <= ia) {
            f32x4 sc = (f32x4){0.f, 0.f, 0.f, 0.f};
            const unsigned kbrow = 16u * (ia * (ia + 1) / 2 + jb);
#pragma unroll
            for (int ks = 0; ks < 4; ++ks) { const bf16x8 kf = *(const LAS bf16x8*)(lds + IM_KB + img256(kbrow + fr, 4 * ks + g)); sc = __builtin_amdgcn_mfma_f32_16x16x32_bf16(kf, qa4[ks], sc, 0, 0, 0); }
            if (jb == ia) {
#pragma unroll
                for (int r = 0; r < 4; ++r) sc[r] = (4 * g + r <= fr) ? sc[r] : 0.f; }
            pw.x = pk2(sc[0], sc[1]); pw.y = pk2(sc[2], sc[3]);
        }
        *(LAS v2u*)(lds + IM_P + imgP(16 * ia + fr, 2 * jb + (g >> 1)) + 8 * (g & 1)) = pw;
    }
    MIX_BAR();
    unsigned char* rec = F.ws + WS_HP + ((size_t)(b * 4 + h) * 32 + n) * HPU;
#pragma unroll
    for (int j = 0; j < 5; ++j) { const int p = tid + 512 * j; *(v4u*)(rec + (size_t)p * 16) = *(const LAS v4u*)(lds + IM_HCOPY(p)); }
    if (tid < 32) *(f32x4*)(rec + 40960 + tid * 16) = *(const LAS f32x4*)(lastv + 4 * tid);
    MIX_BAR();
}

__device__ __forceinline__ void phase_ssd_dt(Frame& F, const Args& A, int l) {
    const float* DT = (const float*)(F.ws + WS_DT); f32x4* SD = (f32x4*)(F.ws + WS_SD);
    const int gw = F.bid * NWAVES + F.wave, NGW = F.G * NWAVES, lane = F.lane;
    for (int it = gw; it < 8 * 16 * (SEQ / 64); it += NGW) { const int n = it & 31, h = (it >> 5) & 15, b = it >> 9;
        const float dtb = A.in[I_DTB][l * 16 + h], Aneg = -__expf(A.in[I_ALOG][l * 16 + h]);
        const float xdt = DT[((size_t)b * SEQ + n * 64 + lane) * 16 + h] + dtb;
        const float dt = xdt > 20.f ? xdt : log1pf(__expf(xdt));
        float cum = dt * Aneg;
#pragma unroll
        for (int o = 1; o < 64; o <<= 1) { const float tmp = __shfl_up(cum, o); if (lane >= o) cum += tmp; }
        const float wl = __expf(__shfl(cum, 63) - cum);
        SD[((size_t)(b * 16 + h)) * SEQ + n * 64 + lane] = (f32x4){dt, cum, wl, __expf(cum)}; }
}
template <int TYPE>
__device__ __forceinline__ void mix_stream(Frame& F, const Args& A, int l, int b, int h, int half) {
    LAS unsigned char* lds = F.lds;
    const bf16* P = (const bf16*)(F.ws + WS_P); bf16* MO = (bf16*)(F.ws + WS_U);
    LAS float* cumv = (LAS float*)(lds + SM_CUM); LAS float* totv = (LAS float*)(lds + SM_TOT); LAS float* lastv = (LAS float*)(lds + SM_LAST);
    const int tid = F.tid, w = F.wave, lane = F.lane;
    const int ia = w >> 1, cc0 = (w & 1) * 2;
    const int ocol = TYPE == MX_RET ? h * 128 + half * 64 : (TYPE == MX_SSD ? 512 + h * 64 : 1536 + h * 128 + half * 64);
    f32x4 S[4];
#pragma unroll
    for (int c = 0; c < 4; ++c) S[c] = (f32x4){0.f, 0.f, 0.f, 0.f};
    for (int i = tid; i < 1024; i += NWAVES * 64) ((LAS v4u*)(lds + IM_ST))[i] = (v4u){0u, 0u, 0u, 0u};
    const int pt = tid >> 3, pib = tid & 7;
    float vs_scale = 1.f;
    float dtb = 0.f, Aneg = 0.f, dsk = 0.f;
    if constexpr (TYPE == MX_RET) {
        const float lg2 = log2f(1.f - exp2f(-5.f - (float)h));
        vs_scale = exp2f((float)(63 - pt) * lg2);
        if (tid < 64) cumv[tid] = (float)(tid + 1) * lg2 * 0.6931471805599453f;
    }
    if constexpr (TYPE == MX_SSD) {
        dtb = A.in[I_DTB][l * 16 + h]; Aneg = -__expf(A.in[I_ALOG][l * 16 + h]); dsk = A.in[I_SSDD][l * 16 + h];
    }
    const float* cosT = (const float*)(F.ws + WS_ROT); const float* sinT = (const float*)(F.ws + WS_ROT + SZ_ROT);
    v4u rq0, rq1, rk0, rk1, rv; f32x4 rc0, rc1, rs0, rs1;
    f32x4 rsd = (f32x4){0.f, 0.f, 0.f, 0.f};
    v4u hp[5]; f32x4 hlv = (f32x4){0.f, 0.f, 0.f, 0.f};
#define MIX_LOAD(nn) do { const int t0n = (nn) * 64; const size_t row0n = (size_t)b * SEQ + t0n; \
        if constexpr (TYPE == MX_RET) { const size_t pr_ = row0n + pt; \
            rq0 = *(const v4u*)(P + PB(pr_, C_RQ + h * 128 + 8 * pib)); rq1 = *(const v4u*)(P + PB(pr_, C_RQ + h * 128 + 64 + 8 * pib)); \
            rk0 = *(const v4u*)(P + PB(pr_, C_RK + h * 128 + 8 * pib)); rk1 = *(const v4u*)(P + PB(pr_, C_RK + h * 128 + 64 + 8 * pib)); \
            rv = *(const v4u*)(P + PB(pr_, C_RV + h * 128 + half * 64 + 8 * pib)); \
            const f32x4* cp = (const f32x4*)(cosT + (size_t)(t0n + pt) * 64 + 8 * pib); const f32x4* sp = (const f32x4*)(sinT + (size_t)(t0n + pt) * 64 + 8 * pib); \
            rc0 = cp[0]; rc1 = cp[1]; rs0 = sp[0]; rs1 = sp[1]; } \
        if constexpr (TYPE == MX_SSD) { rsd = ((const f32x4*)(F.ws + WS_SD))[(size_t)(b * 16 + h) * SEQ + t0n + lane]; \
            const bf16* xc = (const bf16*)(F.ws + WS_XC) + (row0n + pt) * CONVD; const int grp_ = h >> 3; \
            rq0 = *(const v4u*)(xc + 1280 + grp_ * 128 + 8 * pib); rq1 = *(const v4u*)(xc + 1280 + grp_ * 128 + 64 + 8 * pib); \
            rk0 = *(const v4u*)(xc + 1024 + grp_ * 128 + 8 * pib); rk1 = *(const v4u*)(xc + 1024 + grp_ * 128 + 64 + 8 * pib); \
            rv = *(const v4u*)(xc + h * 64 + 8 * pib); } \
        if constexpr (TYPE == MX_HGRN) { const unsigned char* rec = F.ws + WS_HP + ((size_t)(b * 4 + h) * 32 + (nn)) * HPU; \
            _Pragma("unroll") for (int j = 0; j < 5; ++j) hp[j] = *(const v4u*)(rec + (size_t)(tid + 512 * j) * 16); \
            if (tid < 32) hlv = *(const f32x4*)(rec + 40960 + tid * 16); \
            rv = *(const v4u*)(P + PB(row0n + pt, C_HI + h * 128 + half * 64 + 8 * pib)); } \
    } while (0)
    MIX_LOAD(0);
    MIX_BAR();

    for (int n = 0; n < SEQ / 64; ++n) {
        const int t0 = n * 64; const size_t row0 = (size_t)b * SEQ + t0;
        int lz = lane; asm volatile("" : "+v"(lz));
        const int fr = lz & 15, g = lz >> 4, q4 = fr >> 2, p4 = fr & 3;
        bf16 zr[2][4];
        if constexpr (TYPE == MX_SSD) {
#pragma unroll
            for (int cc = 0; cc < 2; ++cc)
#pragma unroll
                for (int r = 0; r < 4; ++r) zr[cc][r] = P[PB(row0 + 16 * ia + 4 * g + r, C_SZ + h * 64 + 16 * (cc0 + cc) + fr)];
        }
        if constexpr (TYPE == MX_RET) {
            float ql[8], qh[8], kl[8], kh[8], vv[8], cs[8], sn[8], o0[8], o1[8];
            unpack8(rq0, ql); unpack8(rq1, qh); unpack8(rk0, kl); unpack8(rk1, kh); unpack8(rv, vv);
#pragma unroll
            for (int e = 0; e < 4; ++e) { cs[e] = rc0[e]; cs[4 + e] = rc1[e]; sn[e] = rs0[e]; sn[4 + e] = rs1[e]; }
#pragma unroll
            for (int e = 0; e < 8; ++e) { o0[e] = ql[e] * cs[e] - qh[e] * sn[e]; o1[e] = ql[e] * sn[e] + qh[e] * cs[e]; }
            *(LAS v4u*)(lds + IM_QA + img256(pt, pib)) = pack8(o0); *(LAS v4u*)(lds + IM_QA + img256(pt, 8 + pib)) = pack8(o1);
#pragma unroll
            for (int e = 0; e < 8; ++e) { o0[e] = (kl[e] * cs[e] - kh[e] * sn[e]) * 0.08838834764831845f; o1[e] = (kl[e] * sn[e] + kh[e] * cs[e]) * 0.08838834764831845f; }
            *(LAS v4u*)(lds + IM_KB + img256(pt, pib)) = pack8(o0); *(LAS v4u*)(lds + IM_KB + img256(pt, 8 + pib)) = pack8(o1);
            *(LAS v4u*)(lds + IM_V + imgV(pt, pib)) = pack8(vv);
#pragma unroll
            for (int e = 0; e < 8; ++e) vv[e] *= vs_scale;
            *(LAS v4u*)(lds + IM_VS + imgV(pt, pib)) = pack8(vv);
        }
        if constexpr (TYPE == MX_SSD) {
            if (w == 0) { cumv[lane] = rsd[1]; cumv[64 + lane] = rsd[3]; }
            const float sdt = __shfl(rsd[0], pt), swl = __shfl(rsd[2], pt);
            float kl[8], kh[8], vv[8];
            unpack8(rk0, kl); unpack8(rk1, kh); unpack8(rv, vv);
            *(LAS v4u*)(lds + IM_QA + img256(pt, pib)) = rq0; *(LAS v4u*)(lds + IM_QA + img256(pt, 8 + pib)) = rq1;
#pragma unroll
            for (int e = 0; e < 8; ++e) { kl[e] *= sdt; kh[e] *= sdt; }
            *(LAS v4u*)(lds + IM_KB + img256(pt, pib)) = pack8(kl); *(LAS v4u*)(lds + IM_KB + img256(pt, 8 + pib)) = pack8(kh);
            *(LAS v4u*)(lds + IM_V + imgV(pt, pib)) = rv;
#pragma unroll
            for (int e = 0; e < 8; ++e) vv[e] *= swl;
            *(LAS v4u*)(lds + IM_VS + imgV(pt, pib)) = pack8(vv);
        }
        if constexpr (TYPE == MX_HGRN) {
#pragma unroll
            for (int j = 0; j < 5; ++j) *(LAS v4u*)(lds + IM_HCOPY(tid + 512 * j)) = hp[j];
            *(LAS v4u*)(lds + IM_V + imgV(pt, pib)) = rv;
            if (tid < 32) *(LAS f32x4*)(lastv + 4 * tid) = hlv;
        }
        { const int nn = n + 1 < SEQ / 64 ? n + 1 : n; MIX_LOAD(nn); }
        MIX_BAR();
        bf16x8 qa[4];
#pragma unroll
        for (int ks = 0; ks < 4; ++ks) qa[ks] = *(const LAS bf16x8*)(lds + IM_QA + img256(16 * ia + fr, 4 * ks + g));
#pragma unroll
        for (int jj = 0; jj < 2; ++jj) if (TYPE != MX_HGRN) { const int jb = cc0 + jj; v2u pw = (v2u){0u, 0u};
            if (jb <= ia) {
                f32x4 sc = (f32x4){0.f, 0.f, 0.f, 0.f};
                const unsigned kbrow = TYPE == MX_HGRN ? 16u * (ia * (ia + 1) / 2 + jb) : 16u * jb;
#pragma unroll
                for (int ks = 0; ks < 4; ++ks) { const bf16x8 kf = *(const LAS bf16x8*)(lds + IM_KB + img256(kbrow + fr, 4 * ks + g)); sc = __builtin_amdgcn_mfma_f32_16x16x32_bf16(kf, qa[ks], sc, 0, 0, 0); }
                if constexpr (TYPE != MX_HGRN) { const float ci = cumv[16 * ia + fr]; const f32x4 cj = *(const LAS f32x4*)(cumv + 16 * jb + 4 * g);
#pragma unroll
                    for (int r = 0; r < 4; ++r) sc[r] *= __expf(fminf(ci - cj[r], 0.f)); }
                if (jb == ia) {
#pragma unroll
                    for (int r = 0; r < 4; ++r) sc[r] = (4 * g + r <= fr) ? sc[r] : 0.f; }
                pw.x = pk2(sc[0], sc[1]); pw.y = pk2(sc[2], sc[3]);
            }
            *(LAS v2u*)(lds + IM_P + imgP(16 * ia + fr, 2 * jb + (g >> 1)) + 8 * (g & 1)) = pw;
        }
        f32x4 qs[2];
        {
            bf16x8 qb[4];
            if constexpr (TYPE == MX_HGRN) {
#pragma unroll
                for (int ks = 0; ks < 4; ++ks) qb[ks] = *(const LAS bf16x8*)(lds + IM_QB + img256(16 * ia + fr, 4 * ks + g));
            } else {
#pragma unroll
                for (int ks = 0; ks < 4; ++ks) qb[ks] = qa[ks];
            }
#pragma unroll
            for (int cc = 0; cc < 2; ++cc) { qs[cc] = (f32x4){0.f, 0.f, 0.f, 0.f};
#pragma unroll
                for (int ks = 0; ks < 4; ++ks) { const bf16x8 sf = *(const LAS bf16x8*)(lds + IM_ST + img256(16 * (cc0 + cc) + fr, 4 * ks + g)); qs[cc] = __builtin_amdgcn_mfma_f32_16x16x32_bf16(qb[ks], sf, qs[cc], 0, 0, 0); } }
        }
        MIX_BAR();
        {
            const unsigned tra0 = (unsigned)(8 * g + q4), trc = (unsigned)(p4 >> 1), trb = 8u * (unsigned)(p4 & 1);
#pragma unroll
            for (int cc = 0; cc < 2; ++cc) { const int c = cc0 + cc; f32x4 pv = (f32x4){0.f, 0.f, 0.f, 0.f};
#pragma unroll
                for (int ks = 0; ks < 2; ++ks) if (ks == 0 || ia >= 2) {
                    const bf16x8 pf = *(const LAS bf16x8*)(lds + IM_P + imgP(16 * ia + fr, 4 * ks + g));
                    const bf16x8 vf = tr_pair(lds + IM_V, imgV(32 * ks + tra0, 2 * c + trc) + trb, imgV(32 * ks + tra0 + 4, 2 * c + trc) + trb);
                    pv = __builtin_amdgcn_mfma_f32_16x16x32_bf16(pf, vf, pv, 0, 0, 0); }
#pragma unroll
                for (int r = 0; r < 4; ++r) { const int i = 16 * ia + 4 * g + r, v = 16 * c + fr; float o;
                    if constexpr (TYPE == MX_HGRN) o = pv[r] + qs[cc][r]; else if constexpr (TYPE == MX_SSD) o = pv[r] + cumv[64 + i] * qs[cc][r]; else o = pv[r] + __expf(cumv[i]) * qs[cc][r];
                    if constexpr (TYPE == MX_SSD) { const float xv = bf2f(*(const LAS bf16*)(lds + IM_V + imgV(i, v >> 3) + (v & 7) * 2)); o = (o + dsk * xv) * siluf(bf2f(zr[cc][r])); }
                    MO[(row0 + i) * DM + ocol + v] = f2bf1(o); }
            }
            if constexpr (TYPE == MX_HGRN) { const f32x4 d = *(const LAS f32x4*)(lastv + 16 * w + 4 * g);
#pragma unroll
                for (int c = 0; c < 4; ++c) S[c] = S[c] * d; }
            else { const float d = TYPE == MX_SSD ? cumv[64 + 63] : __expf(cumv[63]);
#pragma unroll
                for (int c = 0; c < 4; ++c) S[c] = S[c] * d; }
            constexpr int IMK = TYPE == MX_HGRN ? IM_KS : IM_KB, IMV2 = TYPE == MX_HGRN ? IM_V : IM_VS;
#pragma unroll
            for (int ks = 0; ks < 2; ++ks) {
                const bf16x8 af = tr_pair(lds + IMK, img256(32 * ks + tra0, 2 * w + trc) + trb, img256(32 * ks + tra0 + 4, 2 * w + trc) + trb);
#pragma unroll
                for (int c = 0; c < 4; ++c) { const bf16x8 bv = tr_pair(lds + IMV2, imgV(32 * ks + tra0, 2 * c + trc) + trb, imgV(32 * ks + tra0 + 4, 2 * c + trc) + trb);
                    S[c] = __builtin_amdgcn_mfma_f32_16x16x32_bf16(af, bv, S[c], 0, 0, 0); } }
        }
        MIX_BAR();
#pragma unroll
        for (int c = 0; c < 4; ++c) { v2u sw; sw.x = pk2(S[c][0], S[c][1]); sw.y = pk2(S[c][2], S[c][3]);
            *(LAS v2u*)(lds + IM_ST + img256(16 * c + fr, 2 * w + (g >> 1)) + 8 * (g & 1)) = sw; }
    }
    VM_WAIT(); MIX_BAR();
#undef MIX_LOAD
}

__device__ __forceinline__ void phase_mix(Frame& F, const Args& A, int l) {
    { const int s = F.bid;
        if (s < 64) { { const int x = s & 7, j = s >> 3, pr = (j >> 1) * 8 + x; mix_stream<MX_RET>(F, A, l, pr >> 2, pr & 3, j & 1); }     }
        else if (s < 192) { const int sb = s - 64; { const int x = sb & 7, j = sb >> 3, pg = (j >> 3) * 8 + x; mix_stream<MX_SSD>(F, A, l, pg >> 1, (pg & 1) * 8 + (j & 7), 0); }     }
        else { const int sb = s - 192; { const int x = sb & 7, j = sb >> 3, pr = (j >> 1) * 8 + x; mix_stream<MX_HGRN>(F, A, l, pr >> 2, pr & 3, j & 1); } }
    }
}

__device__ __forceinline__ void phase_ssdnorm(Frame& F, const Args& A, int l) {
    bf16* MO = (bf16*)(F.ws + WS_U); const bf16* P = (const bf16*)(F.ws + WS_P);
    const int gw = F.bid * NWAVES + F.wave, NGW = F.G * NWAVES, lane = F.lane;
    const int kind = lane < 16 ? 0 : (lane < 48 ? 1 : 2);
    float wq[32];
    { const float* wp = kind == 1 ? A.in[I_SSDNW] + l * 1024 + 32 * (lane - 16) : A.in[I_HNW] + l * 512 + 32 * ((lane - 48) & 15);
#pragma unroll
        for (int j = 0; j < 32; ++j) wq[j] = kind != 0 ? wp[j] : 1.f; }
    for (int row = gw; row < NTOK; row += 2 * NGW) {
        v4u xin[2][4], gin[2][4];
#pragma unroll
        for (int q = 0; q < 2; ++q) { const size_t rw = (size_t)row + (size_t)q * NGW;
            const v4u* p = (const v4u*)(MO + rw * DM + 32 * lane);
            const v4u* gp = (const v4u*)(P + PB(rw, kind == 0 ? C_RG + 32 * lane : C_HG + 32 * ((lane - 48) & 15)));
#pragma unroll
            for (int c = 0; c < 4; ++c) { xin[q][c] = p[c]; gin[q][c] = kind != 1 ? gp[c] : (v4u){0u, 0u, 0u, 0u}; } }
#pragma unroll
        for (int q = 0; q < 2; ++q) { const size_t rw = (size_t)row + (size_t)q * NGW;
            float f[32];
#pragma unroll
            for (int c = 0; c < 4; ++c) { float t8[8]; unpack8(xin[q][c], t8);
#pragma unroll
                for (int j = 0; j < 8; ++j) f[8 * c + j] = t8[j]; }
            float ss = 0.f;
#pragma unroll
            for (int j = 0; j < 32; ++j) ss += f[j] * f[j];
            ss += __shfl_xor(ss, 1); ss += __shfl_xor(ss, 2);
            float s16 = ss; s16 += __shfl_xor(s16, 4); s16 += __shfl_xor(s16, 8);
            const float rstd = 1.f / sqrtf((kind == 1 ? s16 * (1.f / 512.f) : ss * (1.f / 128.f)) + EPS);
            v4u* po = (v4u*)(MO + rw * DM + 32 * lane);
#pragma unroll
            for (int c = 0; c < 4; ++c) { float o[8], gg[8]; unpack8(gin[q][c], gg);
#pragma unroll
                for (int j = 0; j < 8; ++j) { float v = f[8 * c + j] * rstd * wq[8 * c + j]; if (kind != 1) v *= siluf(gg[j]); o[j] = v; }
                po[c] = pack8(o); }
        }
    }
}

__device__ __forceinline__ void phase_final(Frame& F, const Args& A) {
    const bf16* Y = (const bf16*)(F.ws + WS_Y); const int* slot = (const int*)(F.ws + WS_SLOT);
    build_tables(F, NLAYER - 1);
    const int gw = F.bid * NWAVES + F.wave, NGW = F.G * NWAVES;
    f32x4 wv[8]; load_normw(A.in[I_FINW], wv, F.lane);
    for (int row = gw; row < NTOK; row += 2 * NGW) {
        const float* src[2]; float* hd[2] = {nullptr, nullptr}; const bf16* ya[2]; const bf16* yb[2]; bf16* ud[2] = {nullptr, nullptr}; float* fd[2];
#pragma unroll
        for (int q = 0; q < 2; ++q) { const int rw = row + q * NGW; const int s0 = slot[rw * 2], s1 = slot[rw * 2 + 1];
            ya[q] = Y + ((size_t)F.tab[T_EBASE + (s0 >> 16)] * 256 + (s0 & 0xffff)) * (MOE_FP8 ? DM / 2 : DM); yb[q] = Y + ((size_t)F.tab[T_EBASE + (s1 >> 16)] * 256 + (s1 & 0xffff)) * (MOE_FP8 ? DM / 2 : DM);
            src[q] = H_BF16 ? (const float*)((const bf16*)(F.ws + WS_H) + (size_t)rw * DM) : F.out + (size_t)rw * DM; fd[q] = F.out + (size_t)rw * DM; }
        norm_rows<2, 2, false, H_BF16>(src, hd, ya, yb, wv, ud, fd, F.lane); }
}

constexpr int NPH = 8, GP_TOTAL = 2 + NLAYER * NPH;
__global__ void __launch_bounds__(NWAVES * 64, 2) mk_fwd(Args args) {
    extern __shared__ __attribute__((aligned(16))) unsigned char lds[];
    Frame F;
    F.lds = (LAS unsigned char*)lds;
    F.MISC = (volatile LAS unsigned*)(F.lds + MISC_OFF);
    F.tab = (LAS int*)(F.lds + TAB_OFF);
    F.tid = threadIdx.x; F.lane = F.tid & 63; F.wave = __builtin_amdgcn_readfirstlane(F.tid >> 6);
    F.G = gridDim.x; F.bid = blockIdx.x;
    F.out = args.out; F.ws = args.ws; F.ctl = (unsigned*)(args.ws + WS_CTL);
    for (int u = F.tid; u < (LDS_BYTES - LDSCTL_OFF) / 4; u += NWAVES * 64) ((LAS unsigned*)(F.lds + LDSCTL_OFF))[u] = 0u;
    __syncthreads();
    const int lo = args.gp_lo, hi = args.gp_hi;
    XcdBarrier bar; bar.bar = F.ctl + CW_BAR; bar.x = 0; bar.st = nullptr;
    if (hi - lo > 1) bar = xcd_barrier_post(F.ctl + CW_BAR, F.MISC + 8);
#define IN(k) (lo <= (k) && (k) < hi)
#define SEAM(k) do { if ((k) + 1 < hi) xcd_barrier(bar); } while (0)

    if (IN(0)) { phase_prologue(F, args); SEAM(0); }
#define LAYER_BODY(l, pb) \
        if (IN(pb + 0)) { phase_norm1(F, args, l); SEAM(pb + 0); } \
        if (IN(pb + 1)) { \
            pg8::Gemm g{(const bf16*)(F.ws + WS_U), (const bf16*)(F.ws + WS_WIN + l * SZ_WIN), NTOK, NP, DM, 0u}; pg8::StaticOrder S; \
            pg8::EpiBf16Blk E{(bf16*)(F.ws + WS_P), NTOK}; \
            if (l == 0) { if (F.bid < G1_WGS) { S.init(NTOK, NP, G1_WGS, F.bid); pg8::gemm_phase<pg8::EpiBf16Blk, pg8::StaticOrder, true>(F.lds, g, S, E); } \
                          else convert_items(F, args, CONV_SPLIT, CT_LO, (F.bid - G1_WGS) * NWAVES + F.wave, (F.G - G1_WGS) * NWAVES); } \
            else { S.init(NTOK, NP, F.G, F.bid); pg8::gemm_phase<pg8::EpiBf16Blk, pg8::StaticOrder, true>(F.lds, g, S, E); \
                   if (F.bid >= 128) convert_items(F, args, CT_LO, NLAYER * TI_LAYER, (F.bid - 128) * NWAVES + F.wave, 128 * NWAVES); } \
            SEAM(pb + 1); \
        } \
        if (IN(pb + 2)) { phase_ssd_dt(F, args, l); phase_conv(F, args, l); for (int u = F.bid; u < 1024; u += F.G) hgrn_prep_unit(F, args, l, u >> 7, (u >> 5) & 3, u & 31); xcd_barrier(bar); phase_mix(F, args, l); SEAM(pb + 2); } \
        if (IN(pb + 3)) { phase_ssdnorm(F, args, l); SEAM(pb + 3); } \
        if (IN(pb + 4)) { \
            pg8::Gemm g{(const bf16*)(F.ws + WS_U), (const bf16*)(F.ws + WS_WOUT + l * SZ_WOUT), NTOK, DM, DM, 0u}; pg8::StaticOrder S; S.init(NTOK, DM, F.G, F.bid); \
            if (H_BF16) { if (l == 0) { pg8::EpiResH<true> E{args.in[I_X], (bf16*)(F.ws + WS_H), DM}; pg8::gemm_phase<pg8::EpiResH<true>, pg8::StaticOrder, true>(F.lds, g, S, E); } \
                          else { pg8::EpiResH<false> E{(const void*)(F.ws + WS_H), (bf16*)(F.ws + WS_H), DM}; pg8::gemm_phase<pg8::EpiResH<false>, pg8::StaticOrder, true>(F.lds, g, S, E); } } \
            else { pg8::EpiResF32 E{l == 0 ? args.in[I_X] : F.out, F.out, DM}; pg8::gemm_phase<pg8::EpiResF32, pg8::StaticOrder, false>(F.lds, g, S, E); } \
            SEAM(pb + 4); \
        } \
        if (IN(pb + 5)) { phase_norm2(F, args, l); SEAM(pb + 5); } \
        if (IN(pb + 6)) { \
            build_tables(F, l); \
            const int ntiles = (int)F.MISC[16]; \
            const int* tokl = (const int*)(F.ws + WS_TOK); \
            for (int i = 0; i < 4; ++i) { const int L = i * F.G + F.bid; if (L < ntiles * 4) { const int v = F.tab[T_TMAP + L / 4], e = v >> 8, lt = v & 255, cnt = F.tab[T_ECNT + e]; \
                for (int r = F.tid; r < 256; r += NWAVES * 64) { const int lr = lt * 256 + r; F.tab[T_GTAB + i * 256 + r] = tokl[(size_t)e * NTOK + (lr < cnt ? lr : 0)]; } } } \
            __syncthreads(); \
            pg8::MoeOrder<true> S{F.tab + T_TMAP, F.tab + T_GTAB, ntiles, 4, F.G, F.bid, SZ_WGU1}; \
            if (MOE_FP8) { pg8::Gemm g{(const bf16*)(F.ws + WS_U8), (const bf16*)(F.ws + WS_WGU + (size_t)l * NEXP * SZ_WGU1), PADROWS, 1024, DM / 2, 0x79797979u}; \
                pg8::EpiSwiGlu8 E{F.ws + WS_HID}; pg8::gemm_phase<pg8::EpiSwiGlu8, pg8::MoeOrder<true>, true, true>(F.lds, g, S, E); } \
            else { pg8::Gemm g{(const bf16*)(F.ws + WS_U), (const bf16*)(F.ws + WS_WGU + (size_t)l * NEXP * SZ_WGU1), PADROWS, 1024, DM, 0u}; \
                pg8::EpiSwiGlu E{(bf16*)(F.ws + WS_HID)}; pg8::gemm_phase<pg8::EpiSwiGlu, pg8::MoeOrder<true>, true>(F.lds, g, S, E); } \
            SEAM(pb + 6); \
        } \
        if (IN(pb + 7)) { \
            build_tables(F, l); \
            const int ntiles = (int)F.MISC[16]; \
            pg8::MoeOrder<false> S{F.tab + T_TMAP, F.tab + T_GTAB, ntiles, 8, F.G, F.bid, SZ_WD1}; \
            pg8::EpiScaleBf16 E{(bf16*)(F.ws + WS_Y), DM, (const float*)(F.ws + WS_WT), F.tab + T_ECNT}; \
            if (MOE_FP8) { pg8::Gemm g{(const bf16*)(F.ws + WS_HID), (const bf16*)(F.ws + WS_WD + (size_t)l * NEXP * SZ_WD1), PADROWS, DM, DEXP / 2, 0x7a7a7a7au}; \
                pg8::EpiScaleF8 E8{F.ws + WS_Y, DM, (const float*)(F.ws + WS_WT), F.tab + T_ECNT}; \
                pg8::gemm_phase<pg8::EpiScaleF8, pg8::MoeOrder<false>, true, true>(F.lds, g, S, E8); } \
            else { pg8::Gemm g{(const bf16*)(F.ws + WS_HID), (const bf16*)(F.ws + WS_WD + (size_t)l * NEXP * SZ_WD1), PADROWS, DM, DEXP, 0u}; \
                pg8::gemm_phase<pg8::EpiScaleBf16, pg8::MoeOrder<false>, true>(F.lds, g, S, E); } \
            SEAM(pb + 7); \
        }
    { constexpr int l = 0, pb = 1; LAYER_BODY(l, pb) }
    { constexpr int l = 1, pb = 1 + NPH; LAYER_BODY(l, pb) }
#undef LAYER_BODY
    if (IN(GP_TOTAL - 1)) phase_final(F, args);
#undef IN
#undef SEAM
}

extern "C" void kernel_launch(void* const* d_in, const int* in_sizes, int n_in, void* d_out, int out_size, void* d_ws, size_t ws_size, hipStream_t stream) {
    static int grid = 0;
    if (grid == 0) {
        if (n_in != 21 || out_size != NTOK * DM || ws_size < WS_END) { fprintf(stderr, "kernel_launch: unexpected shapes (n_in %d, out %d, ws %zu, need %zu)\n", n_in, out_size, ws_size, (size_t)WS_END); grid = -1; return; }
        int dev = 0, cus = 0, per_cu = 0;
        if (hipGetDevice(&dev) != hipSuccess || hipDeviceGetAttribute(&cus, hipDeviceAttributeMultiprocessorCount, dev) != hipSuccess) { grid = -1; return; }
        if (hipFuncSetAttribute((const void*)mk_fwd, hipFuncAttributeMaxDynamicSharedMemorySize, LDS_BYTES) != hipSuccess) { fprintf(stderr, "kernel_launch: hipFuncSetAttribute failed\n"); grid = -1; return; }
        if (hipOccupancyMaxActiveBlocksPerMultiprocessor(&per_cu, (const void*)mk_fwd, NWAVES * 64, LDS_BYTES) != hipSuccess || per_cu < 1) fprintf(stderr, "kernel_launch: occupancy query reports %d\n", per_cu);
        (void)hipGetLastError();
        grid = cus;
        if (grid != 256) { fprintf(stderr, "kernel_launch: built for a 256-CU device (got %d)\n", cus); grid = -1; return; }
    }
    if (grid < 0) return;
    if (hipMemsetAsync((char*)d_ws + WS_CTL, 0, CTL_ZERO_BYTES, stream) != hipSuccess) return;
    Args a{};
    for (int i = 0; i < 21; ++i) a.in[i] = (const float*)d_in[i];
    a.out = (float*)d_out; a.ws = (unsigned char*)d_ws;
#if MK_LAUNCH_PER_PHASE
    for (int p = 0; p < GP_TOTAL; ++p) { a.gp_lo = p; a.gp_hi = p + 1; hipLaunchKernelGGL(mk_fwd, dim3(grid), dim3(NWAVES * 64), LDS_BYTES, stream, a); }
#else
    a.gp_lo = 0; a.gp_hi = GP_TOTAL;
    hipLaunchKernelGGL(mk_fwd, dim3(grid), dim3(NWAVES * 64), LDS_BYTES, stream, a);
#endif
    const hipError_t le = hipPeekAtLastError();
    if (le != hipSuccess) fprintf(stderr, "kernel_launch: launch failed: %s\n", hipGetErrorName(le));
}
```
